# Optimizing an MI355X kernel written in HIP

```python
import jax, jax.numpy as jnp
from jax import lax
import numpy as np

D_MODEL = 1024
BATCH = 16
SEQ = 2048
DEPTH = 1
DEC_BATCH = 1
DEC_SEQ = 16384
PAST_LEN = 128

N_META = 16
GRID_W = 64
Q_BLOCK = 128
ROPE_THETA = 10000.0
EPS = 1e-6

HEADS_A = 8
KV_HEADS_A = 2
HEAD_DIM_A = 128
WIDTH_A = HEADS_A * HEAD_DIM_A

HEADS_B = 8
Q_LORA = 384
KV_LORA = 256
NOPE_B = 128
ROPE_B = 64
V_B = 128
QK_B = NOPE_B + ROPE_B
WIDTH_B = HEADS_B * V_B

IN_SIZES = (WIDTH_A, KV_HEADS_A * HEAD_DIM_A, KV_HEADS_A * HEAD_DIM_A, WIDTH_A,
            Q_LORA, KV_LORA, ROPE_B, WIDTH_B, D_MODEL, D_MODEL)
IN_COLS = sum(IN_SIZES)
SPLIT_IDX = tuple(sum(IN_SIZES[:i + 1]) for i in range(len(IN_SIZES) - 1))

kernel_name = "hybrid_gqa_mla_gated_encoder"


def rms_norm(x, g):
    xf = x.astype(jnp.float32)
    y = xf * lax.rsqrt(jnp.mean(xf * xf, axis=-1, keepdims=True) + EPS)
    return (y * g.astype(jnp.float32)).astype(x.dtype)


def axial_rope_tables(rows, rot_dim):
    axis_dim = rot_dim // 2
    inv_freq = ROPE_THETA ** (-jnp.arange(0, axis_dim, 2, dtype=jnp.float32) / axis_dim)
    row = jnp.repeat(jnp.arange(rows, dtype=jnp.float32), GRID_W)
    col = jnp.tile(jnp.arange(GRID_W, dtype=jnp.float32), rows)
    pad = jnp.zeros((N_META,), jnp.float32)
    row = jnp.concatenate([pad, row])
    col = jnp.concatenate([pad, col])
    ang_r = row[:, None] * inv_freq[None, :]
    ang_c = col[:, None] * inv_freq[None, :]
    return (jnp.cos(ang_r), jnp.sin(ang_r), jnp.cos(ang_c), jnp.sin(ang_c))


def _rotate(y, c, s):
    half = y.shape[-1] // 2
    y1, y2 = y[..., :half], y[..., half:]
    c = c[None, :, None, :]
    s = s[None, :, None, :]
    return jnp.concatenate([y1 * c - y2 * s, y1 * s + y2 * c], axis=-1)


def apply_axial_rope(x, tabs):
    cr, sr, cc, sc = tabs
    d = x.shape[-1] // 2
    xf = x.astype(jnp.float32)
    out = jnp.concatenate([_rotate(xf[..., :d], cr, sr), _rotate(xf[..., d:], cc, sc)], axis=-1)
    return out.astype(x.dtype)


def _attend(q, k, v):
    scale = q.shape[-1] ** -0.5
    s = jnp.einsum('bqhgd,bkhd->bhgqk', q.astype(jnp.float32), k.astype(jnp.float32)) * scale
    p = jax.nn.softmax(s, axis=-1)
    return jnp.einsum('bhgqk,bkhd->bqhgd', p.astype(v.dtype), v)


def bidir_attention(q, k, v):
    b, l, hk, g, dk = q.shape
    dv = v.shape[-1]
    n = l - N_META
    out_meta = _attend(q[:, :N_META], k, v)
    qb = jnp.moveaxis(q[:, N_META:].reshape(b, n // Q_BLOCK, Q_BLOCK, hk, g, dk), 1, 0)
    ob = lax.map(lambda blk: _attend(blk, k, v), qb)
    ob = jnp.moveaxis(ob, 0, 1).reshape(b, n, hk, g, dv)
    return jnp.concatenate([out_meta, ob], axis=1).reshape(b, l, hk * g * dv)


def mixer_layer(h, rope_a, rope_b, norm_gain, w_in, b_merge, q_norm_a, k_norm_a,
                cq_norm, ckv_norm, w_uq, w_ukv, q_norm_b, k_norm_b,
                w_proj_a, w_proj_b, w_out):
    b, l, _ = h.shape
    u = rms_norm(h, norm_gain)
    z = u @ w_in
    qa, ka, va, ga, cq, ckv, kr, gb, ma, mb = jnp.split(z, SPLIT_IDX, axis=-1)

    qa = apply_axial_rope(rms_norm(qa.reshape(b, l, HEADS_A, HEAD_DIM_A), q_norm_a), rope_a)
    ka = apply_axial_rope(rms_norm(ka.reshape(b, l, KV_HEADS_A, HEAD_DIM_A), k_norm_a), rope_a)
    va = va.reshape(b, l, KV_HEADS_A, HEAD_DIM_A)
    qa = qa.reshape(b, l, KV_HEADS_A, HEADS_A // KV_HEADS_A, HEAD_DIM_A)
    oa = bidir_attention(qa, ka, va)
    ya = (oa * jax.nn.silu(ga)) @ w_proj_a

    qb = (rms_norm(cq, cq_norm) @ w_uq).reshape(b, l, HEADS_B, QK_B)
    kvb = (rms_norm(ckv, ckv_norm) @ w_ukv).reshape(b, l, HEADS_B, NOPE_B + V_B)
    k_nope, vb = kvb[..., :NOPE_B], kvb[..., NOPE_B:]
    kb = jnp.concatenate([k_nope, jnp.broadcast_to(kr[:, :, None, :], (b, l, HEADS_B, ROPE_B))], axis=-1)
    qb = rms_norm(qb, q_norm_b)
    kb = rms_norm(kb, k_norm_b)
    qb = jnp.concatenate([qb[..., :NOPE_B], apply_axial_rope(qb[..., NOPE_B:], rope_b)], axis=-1)
    kb = jnp.concatenate([kb[..., :NOPE_B], apply_axial_rope(kb[..., NOPE_B:], rope_b)], axis=-1)
    ob = bidir_attention(qb[:, :, :, None, :], kb, vb)
    yb = (ob * jax.nn.silu(gb)) @ w_proj_b

    gate_a = jax.nn.sigmoid(ma + b_merge[0])
    gate_b = jax.nn.sigmoid(mb + b_merge[1])
    return h + (gate_a * ya + gate_b * yb) @ w_out


def encode(x, meta_tokens, norm_gain, w_in, b_merge, q_norm_a, k_norm_a, cq_norm, ckv_norm,
           w_uq, w_ukv, q_norm_b, k_norm_b, w_proj_a, w_proj_b, w_out):
    b, n, _ = x.shape
    rows = n // GRID_W
    rope_a = axial_rope_tables(rows, HEAD_DIM_A)
    rope_b = axial_rope_tables(rows, ROPE_B)
    meta = jnp.broadcast_to(meta_tokens[None].astype(x.dtype), (b, N_META, D_MODEL))
    h = jnp.concatenate([meta, x], axis=1)
    for i in range(DEPTH):
        h = mixer_layer(h, rope_a, rope_b, norm_gain[i], w_in[i], b_merge[i], q_norm_a[i], k_norm_a[i],
                        cq_norm[i], ckv_norm[i], w_uq[i], w_ukv[i], q_norm_b[i], k_norm_b[i],
                        w_proj_a[i], w_proj_b[i], w_out[i])
    return h[:, N_META:]


def setup_inputs(seed: int = 0) -> dict:
    key = jax.random.key(seed)
    ks = jax.random.split(key, 18)
    f32 = jnp.float32

    def nrm(k, shape, scale):
        return jax.random.normal(k, shape, f32) * scale

    def gain(k, shape):
        return 1.0 + 0.02 * jax.random.normal(k, shape, f32)

    return {
        "x_prompt": nrm(ks[0], (BATCH, SEQ, D_MODEL), 1.0),
        "x_sample": nrm(ks[1], (DEC_BATCH, DEC_SEQ, D_MODEL), 1.0),
        "meta_tokens": nrm(ks[2], (N_META, D_MODEL), 1.0),
        "norm_gain": gain(ks[3], (DEPTH, D_MODEL)),
        "w_in": nrm(ks[4], (DEPTH, D_MODEL, IN_COLS), D_MODEL ** -0.5),
        "b_merge": nrm(ks[5], (DEPTH, 2, D_MODEL), 0.1),
        "q_norm_a": gain(ks[6], (DEPTH, HEAD_DIM_A)),
        "k_norm_a": gain(ks[7], (DEPTH, HEAD_DIM_A)),
        "cq_norm": gain(ks[8], (DEPTH, Q_LORA)),
        "ckv_norm": gain(ks[9], (DEPTH, KV_LORA)),
        "w_uq": nrm(ks[10], (DEPTH, Q_LORA, HEADS_B * QK_B), Q_LORA ** -0.5),
        "w_ukv": nrm(ks[11], (DEPTH, KV_LORA, HEADS_B * (NOPE_B + V_B)), KV_LORA ** -0.5),
        "q_norm_b": gain(ks[12], (DEPTH, QK_B)),
        "k_norm_b": gain(ks[13], (DEPTH, QK_B)),
        "w_proj_a": nrm(ks[14], (DEPTH, WIDTH_A, D_MODEL), WIDTH_A ** -0.5),
        "w_proj_b": nrm(ks[15], (DEPTH, WIDTH_B, D_MODEL), WIDTH_B ** -0.5),
        "w_out": nrm(ks[16], (DEPTH, D_MODEL, D_MODEL), D_MODEL ** -0.5),
    }


def reference(x_prompt, x_sample, meta_tokens, norm_gain, w_in, b_merge, q_norm_a, k_norm_a,
              cq_norm, ckv_norm, w_uq, w_ukv, q_norm_b, k_norm_b, w_proj_a, w_proj_b, w_out):
    y_prompt = encode(x_prompt, meta_tokens, norm_gain, w_in, b_merge, q_norm_a, k_norm_a, cq_norm, ckv_norm,
                      w_uq, w_ukv, q_norm_b, k_norm_b, w_proj_a, w_proj_b, w_out)
    y_sample = encode(x_sample, meta_tokens, norm_gain, w_in, b_merge, q_norm_a, k_norm_a, cq_norm, ckv_norm,
                      w_uq, w_ukv, q_norm_b, k_norm_b, w_proj_a, w_proj_b, w_out)
    return (y_prompt, y_sample)
```

```cpp
#include <hip/hip_runtime.h>
#include <hip/hip_bf16.h>
#include <hip/hip_cooperative_groups.h>
#include <cstdio>
#include <cstdint>
namespace cg = cooperative_groups;

using bf16 = __hip_bfloat16;
using bf16x8 = __attribute__((ext_vector_type(8))) short;
using s16x4  = __attribute__((ext_vector_type(4))) short;
using f32x16 = __attribute__((ext_vector_type(16))) float;
using f32x4  = __attribute__((ext_vector_type(4))) float;
using u32x4  = __attribute__((ext_vector_type(4))) unsigned;
using u32x2  = __attribute__((ext_vector_type(2))) unsigned;
#define DEV __device__ __forceinline__
#define SBAR() __builtin_amdgcn_sched_barrier(0)
#define LAS __attribute__((address_space(3)))

constexpr int DM = 1024;
constexpr int NREAL = 49152;
constexpr int TP = 16384;
constexpr int NHB = NREAL + 256;
constexpr int NCOL = 6400;
constexpr float EPS = 1e-6f;
constexpr float QSCALE_A = 0.088388347648318440f * 1.4426950408889634f;
constexpr float QSCALE_B = 0.072168783648703220f * 1.4426950408889634f;
constexpr int NTHR = 512;
constexpr int LDS_XB_OFF = 155648;
constexpr int LDS_BYTES = LDS_XB_OFF + 16;

constexpr size_t al256(size_t x) { return (x + 255) & ~(size_t)255; }
constexpr size_t OFF_WIN  = 0;
constexpr size_t OFF_WUQ  = OFF_WIN  + al256((size_t)NCOL * 1024 * 2);
constexpr size_t OFF_WUKV = OFF_WUQ  + al256((size_t)1536 * 384 * 2);
constexpr size_t OFF_WPA  = OFF_WUKV + al256((size_t)2048 * 256 * 2);
constexpr size_t OFF_WPB  = OFF_WPA  + al256((size_t)1024 * 1024 * 2);
constexpr size_t OFF_WO   = OFF_WPB  + al256((size_t)1024 * 1024 * 2);
constexpr size_t OFF_RAR  = OFF_WO   + al256((size_t)1024 * 1024 * 2);
constexpr size_t OFF_RAC  = OFF_RAR  + al256((size_t)257 * 32 * 8);
constexpr size_t OFF_RBR  = OFF_RAC  + al256((size_t)65 * 32 * 8);
constexpr size_t OFF_RBC  = OFF_RBR  + al256((size_t)257 * 16 * 8);
constexpr size_t OFF_RSTD = OFF_RBC  + al256((size_t)65 * 16 * 8);
constexpr size_t OFF_SMALL = OFF_RSTD + al256((size_t)NHB * 4);
constexpr size_t OFF_KAM  = OFF_SMALL + al256((size_t)2688 * 4);
constexpr size_t OFF_VAM  = OFF_KAM  + al256((size_t)64 * 256 * 2);
constexpr size_t OFF_KBM  = OFF_VAM  + al256((size_t)64 * 256 * 2);
constexpr size_t OFF_VBM  = OFF_KBM  + al256((size_t)64 * 1536 * 2);
constexpr size_t OFF_HB   = OFF_VBM  + al256((size_t)64 * 1024 * 2);
constexpr size_t OFF_QA   = OFF_HB   + al256((size_t)NHB * 1024 * 2);
constexpr size_t OFF_GA   = OFF_QA   + al256((size_t)TP * 1024 * 2);
constexpr size_t OFF_GB   = OFF_GA   + al256((size_t)TP * 1024 * 2);
constexpr size_t OFF_SA   = OFF_GB   + al256((size_t)TP * 1024 * 2);
constexpr size_t OFF_SB   = OFF_SA   + al256((size_t)TP * 1024 * 2);
constexpr size_t OFF_MM   = OFF_SB   + al256((size_t)TP * 1024 * 2);
constexpr size_t OFF_VB   = OFF_MM   + al256((size_t)TP * 1024 * 2);
constexpr size_t OFF_QB   = OFF_VB   + al256((size_t)TP * 1024 * 2);
constexpr size_t OFF_KB   = OFF_QB   + al256((size_t)TP * 1536 * 2);
constexpr size_t OFF_KA   = OFF_KB   + al256((size_t)TP * 1536 * 2);
constexpr size_t OFF_VA   = OFF_KA   + al256((size_t)TP * 256 * 2);
constexpr size_t OFF_CQ   = OFF_VA   + al256((size_t)TP * 256 * 2);
constexpr size_t OFF_CKV  = OFF_CQ   + al256((size_t)TP * 384 * 2);
constexpr size_t OFF_KR   = OFF_CKV  + al256((size_t)(TP + 256) * 256 * 2);
constexpr size_t OFF_BAR  = OFF_KR   + al256((size_t)(TP + 256) * 64 * 2);
constexpr size_t BAR_BYTES = 3456 * 4;
constexpr size_t WS_END   = OFF_BAR  + al256(BAR_BYTES);

struct Params {
  const float *x_prompt, *x_sample, *meta, *norm_gain, *w_in, *b_merge, *qna, *kna, *cqn, *ckvn, *w_uq, *w_ukv, *qnb, *knb, *wpa, *wpb, *wo;
  float* out; char* ws;
};

DEV int crow(int r, int hi) { return (r & 3) + 8 * (r >> 2) + 4 * hi; }
DEV unsigned cvtpk(float lo, float hi) { unsigned r; asm("v_cvt_pk_bf16_f32 %0, %1, %2" : "=v"(r) : "v"(lo), "v"(hi)); return r; }
DEV float bf2f(short s) { return __uint_as_float(((unsigned)(unsigned short)s) << 16); }
DEV void st4(bf16* p, float a, float b, float c, float d) { u32x2 w = {cvtpk(a, b), cvtpk(c, d)}; *reinterpret_cast<u32x2*>(p) = w; }
DEV void ld4(const bf16* p, float& a, float& b, float& c, float& d) {
  u32x2 w = *reinterpret_cast<const u32x2*>(p);
  a = __uint_as_float(w[0] << 16); b = __uint_as_float(w[0] & 0xffff0000u); c = __uint_as_float(w[1] << 16); d = __uint_as_float(w[1] & 0xffff0000u);
}
template <typename T> DEV T* uni(T* q) {
  const uint64_t v = (uint64_t)q; unsigned lo = (unsigned)v, hi = (unsigned)(v >> 32);
  asm volatile("" : "+s"(lo), "+s"(hi));
  return (T*)((__attribute__((address_space(1))) T*)(((uint64_t)hi << 32) | lo)); }
DEV int lane_id() { int l; asm volatile("v_mbcnt_lo_u32_b32 %0, -1, 0\n\tv_mbcnt_hi_u32_b32 %0, -1, %0" : "=v"(l)); return l; }
DEV float halfsum(float v) { auto rr = __builtin_amdgcn_permlane32_swap(__float_as_uint(v), __float_as_uint(v), false, false); return __uint_as_float(rr[0]) + __uint_as_float(rr[1]); }
DEV float silu_f(float x) { return x / (1.f + __expf(-x)); }
DEV float sigm_f(float x) { return 1.f / (1.f + __expf(-x)); }

template <int MB, int NB, int WM, int WN, bool SSQ>
DEV void gemm_main(f32x16 (&acc)[MB][NB], float (&ssq)[MB], const bf16* __restrict__ A, int lda,
                   const bf16* __restrict__ W, int ldw, int KT, char* lds, int tid) {
  constexpr int BN = WN * NB * 32; constexpr int NCW = BN / 64;
  const int lane = tid & 63, wid = __builtin_amdgcn_readfirstlane(tid >> 6), r32 = lane & 31, hi = lane >> 5;
  const int wm = wid / WN, wn = wid % WN;
  const int srow = tid >> 3, sslot = tid & 7;
  const unsigned aoff = (unsigned)(srow * lda + sslot * 8) * 2u, woffg = (unsigned)(srow * ldw + sslot * 8) * 2u;
  const int woff = srow * 128 + ((sslot ^ ((srow >> 1) & 7)) << 4);
  bf16x8 sa[4], sw[NCW];
#define GLOAD(kt_) do { _Pragma("unroll") for (int i = 0; i < 4; ++i) sa[i] = *reinterpret_cast<const bf16x8*>((const char*)(A + (long)i * 64 * lda + (kt_) * 64) + aoff); \
    _Pragma("unroll") for (int i = 0; i < NCW; ++i) sw[i] = *reinterpret_cast<const bf16x8*>((const char*)(W + (long)i * 64 * ldw + (kt_) * 64) + woffg); } while (0)
#define LWRITE(b_) do { char* d_ = lds + (b_) * 65536 + woff; \
    _Pragma("unroll") for (int i = 0; i < 4; ++i) *reinterpret_cast<bf16x8*>(d_ + i * 8192) = sa[i]; \
    _Pragma("unroll") for (int i = 0; i < NCW; ++i) *reinterpret_cast<bf16x8*>(d_ + 32768 + i * 8192) = sw[i]; } while (0)
#define LOADF(AF, WF, cb_, ks_) do { const int so = (((ks_) * 2 + hi) ^ swz) << 4; \
    _Pragma("unroll") for (int mb = 0; mb < MB; ++mb) AF[mb] = *reinterpret_cast<const bf16x8*>((cb_) + abase + mb * 4096 + so); \
    _Pragma("unroll") for (int nb = 0; nb < NB; ++nb) WF[nb] = *reinterpret_cast<const bf16x8*>((cb_) + 32768 + wbase + nb * 4096 + so); } while (0)
#define MMA(AF, WF) do { _Pragma("unroll") for (int mb = 0; mb < MB; ++mb) _Pragma("unroll") for (int nb = 0; nb < NB; ++nb) \
      acc[mb][nb] = __builtin_amdgcn_mfma_f32_32x32x16_bf16(WF[nb], AF[mb], acc[mb][nb], 0, 0, 0); } while (0)
  const int swz = (r32 >> 1) & 7;
  const int abase = (wm * MB * 32 + r32) * 128, wbase = (wn * NB * 32 + r32) * 128;
  bf16x8 af0[MB], wf0[NB], af1[MB], wf1[NB];
  GLOAD(0);
  __syncthreads();
  LWRITE(0);
  if (KT > 1) GLOAD(1);
  __syncthreads();
  LOADF(af0, wf0, lds, 0);
  for (int kt = 0; kt < KT; ++kt) {
    const char* cb = lds + (kt & 1) * 65536; const char* nb_ = lds + ((kt + 1) & 1) * 65536;
    LOADF(af1, wf1, cb, 1); SBAR(); MMA(af0, wf0); SBAR();
    LOADF(af0, wf0, cb, 2); SBAR(); MMA(af1, wf1); SBAR();
    if (kt + 1 < KT) LWRITE((kt + 1) & 1);
    if (kt + 2 < KT) GLOAD(kt + 2);
    SBAR();
    LOADF(af1, wf1, cb, 3); SBAR(); MMA(af0, wf0); SBAR();
    __syncthreads();
    if (kt + 1 < KT) LOADF(af0, wf0, nb_, 0);
    SBAR(); MMA(af1, wf1); SBAR();
  }
  __syncthreads();
#undef GLOAD
#undef LWRITE
#undef LOADF
#undef MMA
}

DEV void prep_tr_tile(const float* __restrict__ src, int K, int N, bf16* __restrict__ dst, const float* __restrict__ gain,
                      int kt, int ct, int rowshift, char* lds, int wv) {
  float* T = reinterpret_cast<float*>(lds);
  int tid = wv * 64 + lane_id(); asm volatile("" : "+v"(tid));
  { const int i = tid >> 3, j0 = (tid & 7) * 8;
    const float* s = src + (long)(kt * 64 + i) * N + ct * 64 + j0;
    f32x4 a = *reinterpret_cast<const f32x4*>(s), b = *reinterpret_cast<const f32x4*>(s + 4);
    float g = gain ? gain[kt * 64 + i] : 1.f;
    float* t = T + i * 65 + j0;
    t[0] = a[0] * g; t[1] = a[1] * g; t[2] = a[2] * g; t[3] = a[3] * g; t[4] = b[0] * g; t[5] = b[1] * g; t[6] = b[2] * g; t[7] = b[3] * g; }
  __syncthreads();
  { const int jj = tid >> 3, i0 = (tid & 7) * 8;
    u32x4 w;
    w[0] = cvtpk(T[(i0 + 0) * 65 + jj], T[(i0 + 1) * 65 + jj]); w[1] = cvtpk(T[(i0 + 2) * 65 + jj], T[(i0 + 3) * 65 + jj]);
    w[2] = cvtpk(T[(i0 + 4) * 65 + jj], T[(i0 + 5) * 65 + jj]); w[3] = cvtpk(T[(i0 + 6) * 65 + jj], T[(i0 + 7) * 65 + jj]);
    *reinterpret_cast<u32x4*>(dst + (long)(ct * 64 + jj + rowshift) * K + kt * 64 + i0) = w; }
  __syncthreads();
}

DEV void phase0(const Params& p, char* lds, int wv) {
  char* ws = uni(p.ws);
  int tid = wv * 64 + lane_id(); asm volatile("" : "+v"(tid));
  const int bid = blockIdx.x, G = gridDim.x;
  constexpr int T_WIN = 16 * 99, T_WUQ = 6 * 24, T_WUKV = 4 * 32, T_P = 16 * 16;
  constexpr int T_ALL = T_WIN + T_WUQ + T_WUKV + 3 * T_P;
  for (int t = bid; t < T_ALL; t += G) {
    int u = t;
    if (u < T_WIN) { int ct = u % 99, kt = u / 99; prep_tr_tile(uni(p.w_in), 1024, 6336, (bf16*)(ws + OFF_WIN), uni(p.norm_gain), kt, ct, ct > 50 ? 64 : 0, lds, wv); continue; }
    u -= T_WIN;
    if (u < T_WUQ) { int ct = u % 24, kt = u / 24; prep_tr_tile(uni(p.w_uq), 384, 1536, (bf16*)(ws + OFF_WUQ), uni(p.cqn), kt, ct, 0, lds, wv); continue; }
    u -= T_WUQ;
    if (u < T_WUKV) { int ct = u % 32, kt = u / 32; prep_tr_tile(uni(p.w_ukv), 256, 2048, (bf16*)(ws + OFF_WUKV), uni(p.ckvn), kt, ct, 0, lds, wv); continue; }
    u -= T_WUKV;
    { int which = u / T_P, v = u % T_P, ct = v % 16, kt = v / 16;
      const float* src = which == 0 ? uni(p.wpa) : (which == 1 ? uni(p.wpb) : uni(p.wo));
      bf16* dst = (bf16*)(ws + (which == 0 ? OFF_WPA : (which == 1 ? OFF_WPB : OFF_WO)));
      prep_tr_tile(src, 1024, 1024, dst, nullptr, kt, ct, 0, lds, wv); }
  }
  const int gt = bid * NTHR + tid, GT = G * NTHR;
  for (int i = gt; i < 64 * 1024 / 8; i += GT) reinterpret_cast<u32x4*>(ws + OFF_WIN + (size_t)3264 * 1024 * 2)[i] = u32x4{0, 0, 0, 0};
  for (int i = gt; i < (int)((OFF_HB - OFF_KAM) / 16); i += GT) reinterpret_cast<u32x4*>(ws + OFF_KAM)[i] = u32x4{0, 0, 0, 0};
  { float* sm = (float*)(ws + OFF_SMALL);
    for (int i = gt; i < 2688; i += GT) {
      float v;
      if (i < 2048) v = uni(p.b_merge)[i]; else if (i < 2176) v = uni(p.qna)[i - 2048]; else if (i < 2304) v = uni(p.kna)[i - 2176];
      else if (i < 2496) v = uni(p.qnb)[i - 2304]; else v = uni(p.knb)[i - 2496];
      sm[i] = v; } }
  {
    float2* rar = (float2*)(ws + OFF_RAR); float2* rac = (float2*)(ws + OFF_RAC); float2* rbr = (float2*)(ws + OFF_RBR); float2* rbc = (float2*)(ws + OFF_RBC);
    constexpr int N1 = 257 * 32, N2 = 65 * 32, N3 = 257 * 16, N4 = 65 * 16;
    for (int i = gt; i < N1 + N2 + N3 + N4; i += GT) {
      int u = i; float2* dst; int pos, f, nf, ident;
      if (u < N1) { dst = rar + u; pos = u / 32; f = u % 32; nf = 32; ident = 256; }
      else if ((u -= N1) < N2) { dst = rac + u; pos = u / 32; f = u % 32; nf = 32; ident = 64; }
      else if ((u -= N2) < N3) { dst = rbr + u; pos = u / 16; f = u % 16; nf = 16; ident = 256; }
      else { u -= N3; dst = rbc + u; pos = u / 16; f = u % 16; nf = 16; ident = 64; }
      float c = 1.f, s = 0.f;
      if (pos != ident) {
        float invf = exp2f(-13.287712379549449f * (float)f / (float)nf);
        float ang = (float)pos * invf;
        double rv = (double)ang * 0.15915494309189535; rv -= rint(rv);
        float rf = (float)rv;
        c = __builtin_amdgcn_cosf(rf); s = __builtin_amdgcn_sinf(rf);
      }
      *dst = make_float2(c, s);
    }
  }
  {
    const int lane = tid & 63, gw = bid * 8 + (tid >> 6), GW = G * 8;
    bf16* HB = (bf16*)(ws + OFF_HB); float* RS = (float*)(ws + OFF_RSTD);
    for (int row0 = gw; row0 < NHB; row0 += 2 * GW) {
      f32x4 v[2][4]; float ss[2] = {0.f, 0.f}; bool has[2];
#pragma unroll
      for (int u = 0; u < 2; ++u) {
        const int row = row0 + u * GW;
        const float* src = nullptr;
        if (row < 32768) src = uni(p.x_prompt) + (long)row * 1024;
        else if (row < NREAL) src = uni(p.x_sample) + (long)(row - 32768) * 1024;
        else if (row < NREAL + 16) src = uni(p.meta) + (long)(row - NREAL) * 1024;
        has[u] = (src != nullptr);
#pragma unroll
        for (int j = 0; j < 4; ++j) v[u][j] = src ? *reinterpret_cast<const f32x4*>(src + j * 256 + lane * 4) : f32x4{0, 0, 0, 0};
      }
#pragma unroll
      for (int u = 0; u < 2; ++u) {
        const int row = row0 + u * GW;
#pragma unroll
        for (int j = 0; j < 4; ++j) ss[u] += v[u][j][0] * v[u][j][0] + v[u][j][1] * v[u][j][1] + v[u][j][2] * v[u][j][2] + v[u][j][3] * v[u][j][3];
#pragma unroll
        for (int o = 1; o < 64; o <<= 1) ss[u] += __uint_as_float(__builtin_amdgcn_ds_bpermute((lane ^ o) << 2, __float_as_uint(ss[u])));
        if (row < NHB) {
#pragma unroll
          for (int j = 0; j < 4; ++j) st4(HB + (long)row * 1024 + j * 256 + lane * 4, v[u][j][0], v[u][j][1], v[u][j][2], v[u][j][3]);
          if (lane == 0) RS[row] = has[u] ? rsqrtf(ss[u] * (1.f / 1024.f) + EPS) : 0.f;
        }
      }
    }
  }
}

template <int MODE, int NBLK>
DEV void store_plain(const f32x16* a, float rstd, bf16* dst, const float* bias, int hi) {
#pragma unroll
  for (int nb = 0; nb < NBLK; ++nb)
#pragma unroll
    for (int q = 0; q < 4; ++q) {
      const int col = nb * 32 + 8 * q + 4 * hi;
      float v0 = a[nb][4 * q] * rstd, v1 = a[nb][4 * q + 1] * rstd, v2 = a[nb][4 * q + 2] * rstd, v3 = a[nb][4 * q + 3] * rstd;
      if constexpr (MODE == 1) { v0 = silu_f(v0); v1 = silu_f(v1); v2 = silu_f(v2); v3 = silu_f(v3); }
      if constexpr (MODE == 2) { f32x4 b = *reinterpret_cast<const f32x4*>(bias + col);
        v0 = sigm_f(v0 + b[0]); v1 = sigm_f(v1 + b[1]); v2 = sigm_f(v2 + b[2]); v3 = sigm_f(v3 + b[3]); }
      st4(dst + col, v0, v1, v2, v3);
    }
}
DEV void rope_pair32(f32x16& y1, f32x16& y2, const float2* tab, int hi) {
#pragma unroll
  for (int q = 0; q < 4; ++q) {
    const f32x4 t0 = *reinterpret_cast<const f32x4*>(tab + 8 * q + 4 * hi), t1 = *reinterpret_cast<const f32x4*>(tab + 8 * q + 4 * hi + 2);
    const float cs[4] = {t0[0], t0[2], t1[0], t1[2]}, sn[4] = {t0[1], t0[3], t1[1], t1[3]};
#pragma unroll
    for (int j = 0; j < 4; ++j) { const int r = 4 * q + j; float a = y1[r], b = y2[r]; y1[r] = a * cs[j] - b * sn[j]; y2[r] = a * sn[j] + b * cs[j]; }
  }
}
DEV void rope_in32(f32x16& y, const float2* tab, int hi) {
#pragma unroll
  for (int q = 0; q < 2; ++q) {
    const f32x4 t0 = *reinterpret_cast<const f32x4*>(tab + 8 * q + 4 * hi), t1 = *reinterpret_cast<const f32x4*>(tab + 8 * q + 4 * hi + 2);
    const float cs[4] = {t0[0], t0[2], t1[0], t1[2]}, sn[4] = {t0[1], t0[3], t1[1], t1[3]};
#pragma unroll
    for (int j = 0; j < 4; ++j) { const int r = 4 * q + j; float a = y[r], b = y[r + 8]; y[r] = a * cs[j] - b * sn[j]; y[r + 8] = a * sn[j] + b * cs[j]; }
  }
}
DEV void scale_gain(f32x16& y, float s, const float* gain, int hi) {
#pragma unroll
  for (int q = 0; q < 4; ++q) { const f32x4 g = *reinterpret_cast<const f32x4*>(gain + 8 * q + 4 * hi);
#pragma unroll
    for (int j = 0; j < 4; ++j) y[4 * q + j] *= s * g[j]; }
}
DEV float sumsq(const f32x16& y) { float s = 0.f;
#pragma unroll
  for (int r = 0; r < 16; ++r) s = fmaf(y[r], y[r], s);
  return s; }
DEV void store_blk(const f32x16& y, bf16* dst, int hi) {
#pragma unroll
  for (int q = 0; q < 4; ++q) st4(dst + 8 * q + 4 * hi, y[4 * q], y[4 * q + 1], y[4 * q + 2], y[4 * q + 3]);
}

template <int NEL> DEV float row_ssq(const bf16* row, int hi) {
  float s = 0.f;
#pragma unroll
  for (int c = 0; c < NEL / 16; ++c) { const bf16x8 v = *reinterpret_cast<const bf16x8*>(row + (2 * c + hi) * 8);
#pragma unroll
    for (int e = 0; e < 8; ++e) { const float f = bf2f(v[e]); s = fmaf(f, f, s); } }
  return halfsum(s);
}
constexpr int SPITCH = 272;
DEV void lst4(char* p, float a, float b, float c, float d) { u32x2 w = {cvtpk(a, b), cvtpk(c, d)}; *reinterpret_cast<LAS u32x2*>((LAS char*)p) = w; }
template <int MODE, int NBLK>
DEV void store_plain_l(const f32x16* a, float rstd, char* srow, const float* bias, int hi) {
#pragma unroll
  for (int nb = 0; nb < NBLK; ++nb)
#pragma unroll
    for (int q = 0; q < 4; ++q) {
      const int col = nb * 32 + 8 * q + 4 * hi;
      float v0 = a[nb][4 * q] * rstd, v1 = a[nb][4 * q + 1] * rstd, v2 = a[nb][4 * q + 2] * rstd, v3 = a[nb][4 * q + 3] * rstd;
      if constexpr (MODE == 1) { v0 = silu_f(v0); v1 = silu_f(v1); v2 = silu_f(v2); v3 = silu_f(v3); }
      if constexpr (MODE == 2) { f32x4 b = *reinterpret_cast<const f32x4*>(bias + col);
        v0 = sigm_f(v0 + b[0]); v1 = sigm_f(v1 + b[1]); v2 = sigm_f(v2 + b[2]); v3 = sigm_f(v3 + b[3]); }
      lst4(srow + col * 2, v0, v1, v2, v3);
    }
}
DEV void store_blk_l(const f32x16& y, char* sp, int hi) {
#pragma unroll
  for (int q = 0; q < 4; ++q) lst4(sp + (8 * q + 4 * hi) * 2, y[4 * q], y[4 * q + 1], y[4 * q + 2], y[4 * q + 3]);
}
template <int NCOLS> DEV void flush_strip(const char* strip, bf16* gbase, long ld, int nrows, int lane) {
  constexpr int CP = NCOLS / 8, RPI = 64 / CP, NI = 32 / RPI;
  const int rr = lane / CP, ch = lane % CP;
#pragma unroll
  for (int i = 0; i < NI; ++i) { const int row = i * RPI + rr;
    const u32x4 v = *reinterpret_cast<const LAS u32x4*>((const LAS char*)(strip + row * SPITCH + ch * 16));
    if (row < nrows) *reinterpret_cast<u32x4*>(gbase + (long)row * ld + ch * 8) = v; }
}
DEV void p1_tile(const Params& p, int pass, int mt, int nt, char* lds, int wv) {
  char* ws = uni(p.ws);
  int tid = wv * 64 + lane_id(); asm volatile("" : "+v"(tid));
  const int lane = tid & 63, wid = __builtin_amdgcn_readfirstlane(tid >> 6), r32 = lane & 31, hi = lane >> 5;
  const int wm = wid >> 1, wn = wid & 1;
  const bool meta = (mt == 64);
  const long hb0 = meta ? (long)NREAL : (long)pass * TP + mt * 256;
  const bf16* A = (const bf16*)(ws + OFF_HB) + hb0 * 1024;
  const bf16* W = (const bf16*)(ws + OFF_WIN) + (long)nt * 256 * 1024;
  f32x16 acc[2][4]; float dummy[2] = {0.f, 0.f};
#pragma unroll
  for (int a = 0; a < 2; ++a)
#pragma unroll
    for (int b = 0; b < 4; ++b) acc[a][b] = f32x16{};
  gemm_main<2, 4, 4, 2, false>(acc, dummy, A, 1024, W, 1024, 16, lds, tid);
  const int seg = nt * 2 + wn;
  const float* RS = (const float*)(ws + OFF_RSTD);
  char* strip = lds + wid * (32 * SPITCH);
  char* srow = strip + r32 * SPITCH;
#pragma unroll
  for (int mb = 0; mb < 2; ++mb) {
    const int row0 = (wm * 2 + mb) * 32;
    const int rl = row0 + r32;
    const int tl = mt * 256 + rl;
    const long tl0 = (long)mt * 256 + row0;
    const int nrows = meta ? (row0 == 0 ? 16 : 0) : 32;
    const float rstd = RS[hb0 + rl];
    const int pos = (pass < 2) ? (tl & 2047) : tl;
    const int ridx = meta ? 256 : (pos >> 6), cidx = meta ? 64 : (pos & 63);
    f32x16* a = acc[mb];
    if (seg < 10) {
      const bool isq = seg < 8;
      if (isq && meta) continue;
      float ss = halfsum(sumsq(a[0]) + sumsq(a[1]) + sumsq(a[2]) + sumsq(a[3])) * rstd * rstd;
      const float rn = rsqrtf(ss * (1.f / 128.f) + EPS) * rstd * (isq ? QSCALE_A : 1.f);
      const float* gain = isq ? ((const float*)(ws + OFF_SMALL) + 2048) : ((const float*)(ws + OFF_SMALL) + 2176);
      SBAR();
      scale_gain(a[0], rn, gain, hi); scale_gain(a[1], rn, gain + 32, hi);
      rope_pair32(a[0], a[1], (const float2*)(ws + OFF_RAR) + ridx * 32, hi);
      store_blk_l(a[0], srow, hi); store_blk_l(a[1], srow + 64, hi);
      SBAR();
      scale_gain(a[2], rn, gain + 64, hi); scale_gain(a[3], rn, gain + 96, hi);
      rope_pair32(a[2], a[3], (const float2*)(ws + OFF_RAC) + cidx * 32, hi);
      store_blk_l(a[2], srow + 128, hi); store_blk_l(a[3], srow + 192, hi);
      SBAR();
      if (isq) flush_strip<128>(strip, (bf16*)(ws + OFF_QA) + tl0 * 1024 + seg * 128, 1024, nrows, lane);
      else if (!meta) flush_strip<128>(strip, (bf16*)(ws + OFF_KA) + tl0 * 256 + (seg - 8) * 128, 256, nrows, lane);
      else flush_strip<128>(strip, (bf16*)(ws + OFF_KAM) + (long)row0 * 256 + (seg - 8) * 128, 256, nrows, lane);
    } else if (seg < 12) {
      store_plain_l<0, 4>(a, rstd, srow, nullptr, hi);
      if (!meta) flush_strip<128>(strip, (bf16*)(ws + OFF_VA) + tl0 * 256 + (seg - 10) * 128, 256, nrows, lane);
      else flush_strip<128>(strip, (bf16*)(ws + OFF_VAM) + (long)row0 * 256 + (seg - 10) * 128, 256, nrows, lane);
    } else if (seg < 20) {
      if (!meta) { store_plain_l<1, 4>(a, rstd, srow, nullptr, hi); flush_strip<128>(strip, (bf16*)(ws + OFF_GA) + tl0 * 1024 + (seg - 12) * 128, 1024, 32, lane); }
    } else if (seg < 23) {
      if (!meta) { store_plain_l<0, 4>(a, rstd, srow, nullptr, hi); flush_strip<128>(strip, (bf16*)(ws + OFF_CQ) + tl0 * 384 + (seg - 20) * 128, 384, 32, lane); }
    } else if (seg < 25) {
      const long r0 = meta ? (long)TP + row0 : tl0;
      store_plain_l<0, 4>(a, rstd, srow, nullptr, hi); flush_strip<128>(strip, (bf16*)(ws + OFF_CKV) + r0 * 256 + (seg - 23) * 128, 256, 32, lane);
    } else if (seg == 25) {
      const long r0 = meta ? (long)TP + row0 : tl0;
      store_plain_l<0, 2>(a, rstd, srow, nullptr, hi); flush_strip<64>(strip, (bf16*)(ws + OFF_KR) + r0 * 64, 64, 32, lane);
    } else if (seg < 34) {
      if (!meta) { store_plain_l<1, 4>(a, rstd, srow, nullptr, hi); flush_strip<128>(strip, (bf16*)(ws + OFF_GB) + tl0 * 1024 + (seg - 26) * 128, 1024, 32, lane); }
    } else if (seg < 42) {
      if (!meta) { store_plain_l<2, 4>(a, rstd, srow, ((const float*)(ws + OFF_SMALL)) + (seg - 34) * 128, hi); flush_strip<128>(strip, (bf16*)(ws + OFF_SA) + tl0 * 1024 + (seg - 34) * 128, 1024, 32, lane); }
    } else {
      if (!meta) { store_plain_l<2, 4>(a, rstd, srow, ((const float*)(ws + OFF_SMALL)) + 1024 + (seg - 42) * 128, hi); flush_strip<128>(strip, (bf16*)(ws + OFF_SB) + tl0 * 1024 + (seg - 42) * 128, 1024, 32, lane); }
    }
  }
}
DEV int vblock() { const int G = gridDim.x, b = blockIdx.x; return (G % 8 == 0) ? (b % 8) * (G / 8) + b / 8 : b; }
DEV void phase1(const Params& p, int pass, char* lds, int wv) {
  const int G = gridDim.x;
  if (G == 256) {
    const int v = vblock(), x = v >> 5, sl = v & 31;
    for (int j = sl; j < 200; j += 32) p1_tile(p, pass, 8 * x + (j & 7), j >> 3, lds, wv);
    if (pass == 0 && sl == 31 && x < 4) p1_tile(p, pass, 64, x == 0 ? 4 : (x == 1 ? 5 : (x == 2 ? 11 : 12)), lds, wv);
    return;
  }
  const int nt_real = 64 * 25;
  const int ntiles = nt_real + (pass == 0 ? 4 : 0);
  for (int t = blockIdx.x; t < ntiles; t += gridDim.x) {
    if (t < nt_real) p1_tile(p, pass, t / 25, t % 25, lds, wv);
    else { const int k = t - nt_real; p1_tile(p, pass, 64, k == 0 ? 4 : (k == 1 ? 5 : (k == 2 ? 11 : 12)), lds, wv); }
  }
}

DEV void p2_uq_tile(const Params& p, int pass, int mt, int head, char* lds, int wv) {
  char* ws = uni(p.ws);
  int tid = wv * 64 + lane_id(); asm volatile("" : "+v"(tid));
  const int lane = tid & 63, wid = __builtin_amdgcn_readfirstlane(tid >> 6), r32 = lane & 31, hi = lane >> 5;
  const bf16* A = (const bf16*)(ws + OFF_CQ) + (long)mt * 256 * 384;
  const bf16* W = (const bf16*)(ws + OFF_WUQ) + (long)head * 192 * 384;
  f32x16 acc[1][6]; float ssq[1] = {0.f};
#pragma unroll
  for (int b = 0; b < 6; ++b) acc[0][b] = f32x16{};
  gemm_main<1, 6, 8, 1, false>(acc, ssq, A, 384, W, 384, 6, lds, tid);
  const int rl = wid * 32 + r32, tl = mt * 256 + rl;
  const float rstd = rsqrtf(row_ssq<384>(A + (long)rl * 384, hi) * (1.f / 384.f) + EPS);
  SBAR();
  f32x16* a = acc[0];
  float ss = 0.f;
#pragma unroll
  for (int nb = 0; nb < 6; ++nb) ss += sumsq(a[nb]);
  ss = halfsum(ss) * rstd * rstd;
  const float rn = rsqrtf(ss * (1.f / 192.f) + EPS) * rstd * QSCALE_B;
  const int pos = (pass < 2) ? (tl & 2047) : tl;
  bf16* dst = (bf16*)(ws + OFF_QB) + (long)tl * 1536 + head * 192;
#pragma unroll
  for (int nb = 0; nb < 4; ++nb) { SBAR(); scale_gain(a[nb], rn, ((const float*)(ws + OFF_SMALL) + 2304) + nb * 32, hi); store_blk(a[nb], dst + nb * 32, hi); }
  SBAR();
  scale_gain(a[4], rn, ((const float*)(ws + OFF_SMALL) + 2304) + 128, hi);
  rope_in32(a[4], (const float2*)(ws + OFF_RBR) + (pos >> 6) * 16, hi);
  store_blk(a[4], dst + 128, hi);
  SBAR();
  scale_gain(a[5], rn, ((const float*)(ws + OFF_SMALL) + 2304) + 160, hi);
  rope_in32(a[5], (const float2*)(ws + OFF_RBC) + (pos & 63) * 16, hi);
  store_blk(a[5], dst + 160, hi);
  SBAR();
}
DEV void p2_ukv_tile(const Params& p, int pass, int mt, int head, char* lds, int wv) {
  char* ws = uni(p.ws);
  int tid = wv * 64 + lane_id(); asm volatile("" : "+v"(tid));
  const int lane = tid & 63, wid = __builtin_amdgcn_readfirstlane(tid >> 6), r32 = lane & 31, hi = lane >> 5;
  const int wm = wid >> 1, wn = wid & 1;
  const bool meta = (mt == 64);
  const bf16* A = (const bf16*)(ws + OFF_CKV) + (long)mt * 256 * 256;
  const bf16* W = (const bf16*)(ws + OFF_WUKV) + (long)head * 256 * 256;
  float rstdv[2];
#pragma unroll
  for (int mb = 0; mb < 2; ++mb) rstdv[mb] = rsqrtf(row_ssq<256>(A + (long)((wm * 2 + mb) * 32 + r32) * 256, hi) * (1.f / 256.f) + EPS);
  SBAR();
  f32x16 acc[2][4]; float ssq[2] = {0.f, 0.f};
#pragma unroll
  for (int a = 0; a < 2; ++a)
#pragma unroll
    for (int b = 0; b < 4; ++b) acc[a][b] = f32x16{};
  gemm_main<2, 4, 4, 2, false>(acc, ssq, A, 256, W, 256, 4, lds, tid);
  if (wn == 1) {
#pragma unroll
    for (int mb = 0; mb < 2; ++mb) {
      const int rl = (wm * 2 + mb) * 32 + r32, tl = mt * 256 + rl;
      bf16* vd = meta ? (bf16*)(ws + OFF_VBM) + (long)rl * 1024 + head * 128 : (bf16*)(ws + OFF_VB) + (long)tl * 1024 + head * 128;
      if (!meta || rl < 16) store_plain<0, 4>(acc[mb], rstdv[mb], vd, nullptr, hi);
      SBAR();
    }
    return;
  }
#pragma unroll
  for (int mb = 0; mb < 2; ++mb) {
    const int rl = (wm * 2 + mb) * 32 + r32, tl = mt * 256 + rl;
    const float rstd = rstdv[mb];
    f32x16* a = acc[mb];
    const bool dost = (!meta || rl < 16);
    const bf16* krp = (const bf16*)(ws + OFF_KR) + (long)tl * 64;
    float ss = 0.f;
#pragma unroll
    for (int nb = 0; nb < 4; ++nb) ss += sumsq(a[nb]);
    ss *= rstd * rstd;
#pragma unroll
    for (int q = 0; q < 8; ++q) { float t0, t1, t2, t3; ld4(krp + 8 * q + 4 * hi, t0, t1, t2, t3); ss += t0 * t0 + t1 * t1 + t2 * t2 + t3 * t3; }
    ss = halfsum(ss);
    const float rn0 = rsqrtf(ss * (1.f / 192.f) + EPS), rn = rn0 * rstd;
    const int pos = (pass < 2) ? (tl & 2047) : tl;
    const int ridx = meta ? 256 : (pos >> 6), cidx = meta ? 64 : (pos & 63);
    bf16* kd = meta ? (bf16*)(ws + OFF_KBM) + (long)rl * 1536 + head * 192 : (bf16*)(ws + OFF_KB) + (long)tl * 1536 + head * 192;
#pragma unroll
    for (int nb = 0; nb < 4; ++nb) { SBAR(); scale_gain(a[nb], rn, ((const float*)(ws + OFF_SMALL) + 2496) + nb * 32, hi); if (dost) store_blk(a[nb], kd + nb * 32, hi); }
    SBAR();
#pragma unroll
    for (int h2 = 0; h2 < 2; ++h2) {
      f32x16 kr;
#pragma unroll
      for (int q = 0; q < 4; ++q) { float t0, t1, t2, t3; ld4(krp + h2 * 32 + 8 * q + 4 * hi, t0, t1, t2, t3); kr[4 * q] = t0; kr[4 * q + 1] = t1; kr[4 * q + 2] = t2; kr[4 * q + 3] = t3; }
      scale_gain(kr, rn0, ((const float*)(ws + OFF_SMALL) + 2496) + 128 + h2 * 32, hi);
      rope_in32(kr, (const float2*)(ws + (h2 == 0 ? OFF_RBR : OFF_RBC)) + (h2 == 0 ? ridx : cidx) * 16, hi);
      if (dost) store_blk(kr, kd + 128 + h2 * 32, hi);
      SBAR();
    }
  }
}
DEV void phase2(const Params& p, int pass, char* lds, int wv) {
  const int G = gridDim.x;
  if (G == 256) {
    const int v = vblock(), x = v >> 5, sl = v & 31;
    for (int j = sl; j < 128; j += 32) {
      const int mt = 8 * x + (j & 7), head = (j >> 3) & 7;
      if (j < 64) p2_ukv_tile(p, pass, mt, head, lds, wv); else p2_uq_tile(p, pass, mt, head, lds, wv);
    }
    if (pass == 0 && sl == 0) p2_ukv_tile(p, pass, 64, x, lds, wv);
    return;
  }
  const int n_kv = (64 + (pass == 0 ? 1 : 0)) * 8, n_q = 64 * 8;
  for (int t = blockIdx.x; t < n_kv + n_q; t += gridDim.x) {
    if (t < n_kv) p2_ukv_tile(p, pass, t >> 3, t & 7, lds, wv);
    else { const int u = t - n_kv; p2_uq_tile(p, pass, u >> 3, u & 7, lds, wv); }
  }
}

constexpr int KVBLK = 64;
constexpr float THR = 8.f;
template <int DQK> struct AC {
  static constexpr float SCALE = DQK == 128 ? 0.088388347648318440f : 0.072168783648703220f;
  static constexpr float C = SCALE * 1.4426950408889634f;
  static constexpr int KPITCH = DQK * 2 + 16;
  static constexpr int SHM_K = KVBLK * KPITCH;
};
DEV void partialSM(f32x16& p0) {
#pragma unroll
  for (int r = 0; r < 16; ++r) p0[r] = __builtin_amdgcn_exp2f(p0[r]);
}
DEV void finishSM(f32x16& p0, f32x16& p1, float& l_reg, bf16x8& pa0, bf16x8& pa1, bf16x8& pa2, bf16x8& pa3) {
#pragma unroll
  for (int r = 0; r < 16; ++r) p1[r] = __builtin_amdgcn_exp2f(p1[r]);
  float ps = 0;
#pragma unroll
  for (int r = 0; r < 16; ++r) ps += p0[r];
#pragma unroll
  for (int r = 0; r < 16; ++r) ps += p1[r];
  { auto rr = __builtin_amdgcn_permlane32_swap(__float_as_uint(ps), __float_as_uint(ps), false, false);
    ps = __uint_as_float(rr[0]) + __uint_as_float(rr[1]); }
  l_reg += ps;
#define PK4(P, BASE, OUT) do { unsigned a0 = cvtpk(P[BASE + 0], P[BASE + 1]), a1 = cvtpk(P[BASE + 2], P[BASE + 3]);   \
    unsigned b0 = cvtpk(P[BASE + 4], P[BASE + 5]), b1 = cvtpk(P[BASE + 6], P[BASE + 7]);                              \
    auto r0 = __builtin_amdgcn_permlane32_swap(a0, b0, false, false); auto r1 = __builtin_amdgcn_permlane32_swap(a1, b1, false, false); \
    u32x4 w = {r0[0], r1[0], r0[1], r1[1]}; OUT = *reinterpret_cast<bf16x8*>(&w); } while (0)
  PK4(p0, 0, pa0); PK4(p0, 8, pa1); PK4(p1, 0, pa2); PK4(p1, 8, pa3);
#undef PK4
}
template <int DQK> DEV int koff(int row, int slot) { return row * AC<DQK>::KPITCH + slot * 16; }
constexpr int QPITCH = 272;
template <int DQK>
DEV void qkt(f32x16& p0, f32x16& p1, const char* Ks, const bf16x8* qr, const char* Ql, int r32, int hi) {
  p0 = f32x16{}; p1 = f32x16{};
  constexpr int KP = AC<DQK>::KPITCH;
  if constexpr (DQK == 192) asm volatile("" : "+v"(r32));
  const char* kb = Ks + r32 * KP + hi * 16;
  const char* qb = Ql + r32 * QPITCH + hi * 16;
#pragma unroll
  for (int d0 = 0; d0 < DQK / 16; ++d0) {
    bf16x8 b0 = *reinterpret_cast<const bf16x8*>(kb + d0 * 32);
    bf16x8 b1 = *reinterpret_cast<const bf16x8*>(kb + d0 * 32 + 32 * KP);
    bf16x8 q;
    if (DQK == 128 || d0 < 4) q = qr[d0];
    else q = *reinterpret_cast<const bf16x8*>(qb + (d0 - 4) * 32);
    p0 = __builtin_amdgcn_mfma_f32_32x32x16_bf16(b0, q, p0, 0, 0, 0);
    p1 = __builtin_amdgcn_mfma_f32_32x32x16_bf16(b1, q, p1, 0, 0, 0);
  }
}
DEV int v_st(int k, int c) { const int kk = (k & ~0xC) | ((k & 4) << 1) | ((k & 8) >> 1); return ((kk >> 3) * 4 + (c >> 5)) * 512 + ((kk & 7) * 32 + (c & 31)) * 2; }
DEV int v_rd_base(int lane) { return ((lane & 3) << 3) | (((lane >> 2) & 3) << 6) | (((lane >> 4) & 1) << 5) | (((lane >> 5) & 1) << 8); }
constexpr int v_rd_off(int d0, int ks, int half) { return d0 * 512 + ks * 4096 + half * 2048; }
template <int OFF> DEV s16x4 tr_read(int vb) {
  s16x4 r; asm volatile("ds_read_b64_tr_b16 %0, %1 offset:%2" : "=&v"(r) : "v"(vb), "i"(OFF) : "memory"); return r;
}
template <int D0> DEV void pv_one(f32x16& od, int vb, bf16x8 pa0, bf16x8 pa1, bf16x8 pa2, bf16x8 pa3) {
  const s16x4 l0 = tr_read<v_rd_off(D0, 0, 0)>(vb), h0 = tr_read<v_rd_off(D0, 0, 1)>(vb), l1 = tr_read<v_rd_off(D0, 1, 0)>(vb), h1 = tr_read<v_rd_off(D0, 1, 1)>(vb);
  const s16x4 l2 = tr_read<v_rd_off(D0, 2, 0)>(vb), h2 = tr_read<v_rd_off(D0, 2, 1)>(vb), l3 = tr_read<v_rd_off(D0, 3, 0)>(vb), h3 = tr_read<v_rd_off(D0, 3, 1)>(vb);
  asm volatile("s_waitcnt lgkmcnt(0)" ::: "memory"); SBAR();
#define PK(L, H) (bf16x8){L[0], L[1], L[2], L[3], H[0], H[1], H[2], H[3]}
  od = __builtin_amdgcn_mfma_f32_32x32x16_bf16(pa0, PK(l0, h0), od, 0, 0, 0);
  od = __builtin_amdgcn_mfma_f32_32x32x16_bf16(pa1, PK(l1, h1), od, 0, 0, 0);
  od = __builtin_amdgcn_mfma_f32_32x32x16_bf16(pa2, PK(l2, h2), od, 0, 0, 0);
  od = __builtin_amdgcn_mfma_f32_32x32x16_bf16(pa3, PK(l3, h3), od, 0, 0, 0);
#undef PK
}
struct VF { s16x4 l0, h0, l1, h1, l2, h2, l3, h3; };
template <int D0> DEV void pv_rd(VF& f, int vb) {
  f.l0 = tr_read<v_rd_off(D0, 0, 0)>(vb); f.h0 = tr_read<v_rd_off(D0, 0, 1)>(vb); f.l1 = tr_read<v_rd_off(D0, 1, 0)>(vb); f.h1 = tr_read<v_rd_off(D0, 1, 1)>(vb);
  f.l2 = tr_read<v_rd_off(D0, 2, 0)>(vb); f.h2 = tr_read<v_rd_off(D0, 2, 1)>(vb); f.l3 = tr_read<v_rd_off(D0, 3, 0)>(vb); f.h3 = tr_read<v_rd_off(D0, 3, 1)>(vb);
}
DEV void pv_mm(f32x16& od, const VF& f, bf16x8 pa0, bf16x8 pa1, bf16x8 pa2, bf16x8 pa3) {
#define PK(L, H) (bf16x8){L[0], L[1], L[2], L[3], H[0], H[1], H[2], H[3]}
  od = __builtin_amdgcn_mfma_f32_32x32x16_bf16(pa0, PK(f.l0, f.h0), od, 0, 0, 0);
  od = __builtin_amdgcn_mfma_f32_32x32x16_bf16(pa1, PK(f.l1, f.h1), od, 0, 0, 0);
  od = __builtin_amdgcn_mfma_f32_32x32x16_bf16(pa2, PK(f.l2, f.h2), od, 0, 0, 0);
  od = __builtin_amdgcn_mfma_f32_32x32x16_bf16(pa3, PK(f.l3, f.h3), od, 0, 0, 0);
#undef PK
}
DEV void pv_d0_pipe(f32x16* o, int vb, bf16x8 pa0, bf16x8 pa1, bf16x8 pa2, bf16x8 pa3) {
  VF a, b;
  pv_rd<0>(a, vb); pv_rd<1>(b, vb);
  asm volatile("s_waitcnt lgkmcnt(8)" ::: "memory"); SBAR(); pv_mm(o[0], a, pa0, pa1, pa2, pa3); SBAR();
  pv_rd<2>(a, vb);
  asm volatile("s_waitcnt lgkmcnt(8)" ::: "memory"); SBAR(); pv_mm(o[1], b, pa0, pa1, pa2, pa3); SBAR();
  pv_rd<3>(b, vb);
  asm volatile("s_waitcnt lgkmcnt(8)" ::: "memory"); SBAR(); pv_mm(o[2], a, pa0, pa1, pa2, pa3); SBAR();
  asm volatile("s_waitcnt lgkmcnt(0)" ::: "memory"); SBAR(); pv_mm(o[3], b, pa0, pa1, pa2, pa3); SBAR();
}
DEV void pv_d0(f32x16* o, int vb, bf16x8 pa0, bf16x8 pa1, bf16x8 pa2, bf16x8 pa3) {
  pv_one<0>(o[0], vb, pa0, pa1, pa2, pa3); pv_one<1>(o[1], vb, pa0, pa1, pa2, pa3); pv_one<2>(o[2], vb, pa0, pa1, pa2, pa3); pv_one<3>(o[3], vb, pa0, pa1, pa2, pa3);
}

template <int DQK, int LDQ, int LDK, int LDV, int SD>
DEV void attn_body(const bf16* __restrict__ Qb, const bf16* __restrict__ Kh, const bf16* __restrict__ Vh,
                   const bf16* __restrict__ Km, const bf16* __restrict__ Vm, bf16* Ob, const bf16* __restrict__ Gb, int NT, char* lds, int wv) {
  constexpr int SHM_V = KVBLK * 128 * 2, SHM_K = AC<DQK>::SHM_K, CPR = DQK / 8, NCH = 64 * CPR / NTHR, ND0 = DQK / 16;
  int tid = wv * 64 + lane_id(); asm volatile("" : "+v"(tid));
  const int wid = __builtin_amdgcn_readfirstlane(tid >> 6), lane = tid & 63, r32 = lane & 31, hi = lane >> 5;
  char* V_lds = lds; char* K_lds = lds + 2 * SHM_V;
  float* wsf = (float*)(lds + 2 * SHM_V + 2 * SHM_K) + wid * 64; float* li_l = wsf;
  constexpr int NQR = DQK == 128 ? 8 : 4;
  float l_reg = 0; f32x16 o[4] = {}; bf16x8 qr[NQR];
  const bf16* Qw = Qb + (long)(wid * 32 + r32) * LDQ + hi * 8;
#pragma unroll
  for (int d0 = 0; d0 < NQR; ++d0) qr[d0] = *reinterpret_cast<const bf16x8*>(Qw + d0 * 16);
  char* Ql = lds + 86016 + wid * (32 * QPITCH);
  if constexpr (ND0 > NQR) {
#pragma unroll
    for (int d0 = NQR; d0 < ND0; ++d0)
      *reinterpret_cast<bf16x8*>(Ql + r32 * QPITCH + ((d0 - 4) * 2 + hi) * 16) = *reinterpret_cast<const bf16x8*>(Qw + d0 * 16);
  }
  const int sr = tid >> 4, sc = (tid & 15) * 8, vst0 = v_st(sr, sc);
  const unsigned vgo = (unsigned)(sr * LDV + sc) * 2u;
  const unsigned kgo0 = (unsigned)((tid >> 3) * LDK + (tid & 7) * 8) * 2u; const int kst0 = koff<DQK>(tid >> 3, tid & 7);
  const int vb0 = (int)(uintptr_t)V_lds + v_rd_base(lane);
  struct { u32x4 vs0, vs1, ks[NCH]; } sr_[SD];
  const __amdgpu_buffer_rsrc_t rk_ = __builtin_amdgcn_make_buffer_rsrc((void*)Kh, 0, 0x7fffffff, 0x00020000);
  const __amdgpu_buffer_rsrc_t rv_ = __builtin_amdgcn_make_buffer_rsrc((void*)Vh, 0, 0x7fffffff, 0x00020000);
#define KST(c) (kst0 + (c) * 128)
#define SLOAD0(i) do { const char* kp_ = (const char*)Km; const char* vp_ = (const char*)Vm; \
    sr_[i].vs0 = *reinterpret_cast<const u32x4*>(vp_ + vgo); sr_[i].vs1 = *reinterpret_cast<const u32x4*>(vp_ + 32 * LDV * 2 + vgo); \
    _Pragma("unroll") for (int c = 0; c < NCH; ++c) sr_[i].ks[c] = *reinterpret_cast<const u32x4*>(kp_ + c * 128 + kgo0); } while (0)
#define SLOAD(i, t) do { const int ko_ = ((t) - 1) * (KVBLK * LDK * 2), vo_ = ((t) - 1) * (KVBLK * LDV * 2);     \
    sr_[i].vs0 = __builtin_amdgcn_raw_buffer_load_b128(rv_, (int)vgo, vo_, 0); sr_[i].vs1 = __builtin_amdgcn_raw_buffer_load_b128(rv_, (int)vgo, vo_ + 32 * LDV * 2, 0); \
    _Pragma("unroll") for (int c = 0; c < NCH; ++c) sr_[i].ks[c] = __builtin_amdgcn_raw_buffer_load_b128(rk_, (int)kgo0 + c * 128, ko_, 0); } while (0)
#define SWRITE(b, i) do { *reinterpret_cast<u32x4*>(V_lds + (b) * SHM_V + vst0) = sr_[i].vs0; *reinterpret_cast<u32x4*>(V_lds + (b) * SHM_V + 8192 + vst0) = sr_[i].vs1; \
    _Pragma("unroll") for (int c = 0; c < NCH; ++c) *reinterpret_cast<u32x4*>(K_lds + (b) * SHM_K + KST(c)) = sr_[i].ks[c]; } while (0)
#define SWAIT() do { if constexpr (SD == 2) asm volatile("s_waitcnt vmcnt(%0)" :: "n"(2 + NCH) : "memory"); else asm volatile("s_waitcnt vmcnt(0)" ::: "memory"); } while (0)
  f32x16 pA0, pA1, pB0, pB1; bf16x8 pa0, pa1, pa2, pa3;
  constexpr int SE = 0, SO = SD - 1;
  SLOAD0(SE); asm volatile("s_waitcnt vmcnt(0)" ::: "memory"); SWRITE(0, SE); __syncthreads();
  qkt<DQK>(pA0, pA1, K_lds, qr, Ql, r32, hi);
#pragma unroll
  for (int r = 8; r < 16; ++r) pA0[r] = -1e30f;
#pragma unroll
  for (int r = 0; r < 16; ++r) pA1[r] = -1e30f;
  partialSM(pA0);
  SLOAD(SO, 1); if constexpr (SD == 2) { SLOAD(SE, 2); }
  SWAIT(); SWRITE(1, SO); __syncthreads();
  for (int j = 1; j + 1 < NT; j += 2) {
    SBAR(); qkt<DQK>(pB0, pB1, K_lds + SHM_K, qr, Ql, r32, hi);
    finishSM(pA0, pA1, l_reg, pa0, pa1, pa2, pa3); SBAR();
    if (SD == 1 || j + 2 < NT) SLOAD(SO, j + SD); SBAR();
    if constexpr (DQK == 128) pv_d0_pipe(o, vb0, pa0, pa1, pa2, pa3); else pv_d0(o, vb0, pa0, pa1, pa2, pa3);
    partialSM(pB0);
    __syncthreads(); SWAIT(); SWRITE(0, SE); SBAR();
    __syncthreads();
    SBAR(); qkt<DQK>(pA0, pA1, K_lds, qr, Ql, r32, hi);
    finishSM(pB0, pB1, l_reg, pa0, pa1, pa2, pa3); SBAR();
    if (j + 1 + SD < NT) SLOAD(SE, j + 1 + SD); SBAR();
    if constexpr (DQK == 128) pv_d0_pipe(o, vb0 + SHM_V, pa0, pa1, pa2, pa3); else pv_d0(o, vb0 + SHM_V, pa0, pa1, pa2, pa3);
    partialSM(pA0);
    __syncthreads(); SWAIT(); if (j + 2 < NT) SWRITE(1, SO); SBAR();
    __syncthreads();
  }
  finishSM(pA0, pA1, l_reg, pa0, pa1, pa2, pa3); SBAR();
  pv_d0(o, vb0, pa0, pa1, pa2, pa3);
  {
    const int le = lane_id(), r32e = le & 31, hie = le >> 5;
    if (hie == 0) li_l[r32e] = l_reg; asm volatile("s_waitcnt lgkmcnt(0)" ::: "memory");
    float rli[16];
#pragma unroll
    for (int r = 0; r < 16; ++r) rli[r] = __builtin_amdgcn_rcpf(li_l[crow(r, hie)]);
    const unsigned eoff = (unsigned)((wid * 32 + 4 * hie) * 1024 + r32e) * 2u;
#pragma unroll
    for (int r = 0; r < 16; ++r) {
#pragma unroll
      for (int d0 = 0; d0 < 4; ++d0) {
        const long cst = (long)(((r & 3) + 8 * (r >> 2)) * 1024) * 2 + d0 * 64;
        const float g = bf2f(*reinterpret_cast<const short*>(((const char*)Gb + cst) + eoff));
        const unsigned w = cvtpk(o[d0][r] * rli[r] * g, 0.f);
        *reinterpret_cast<unsigned short*>(((char*)Ob + cst) + eoff) = (unsigned short)(w & 0xffffu); } }
  }
#undef SLOAD
#undef SLOAD0
#undef KST
#undef SWRITE
#undef SWAIT
}
DEV void phase3(const Params& p, int pass, char* lds, int wv) {
  char* ws = uni(p.ws);
  const int nkeys = pass < 2 ? 2048 : 16384, NT = nkeys / 64 + 1;
  for (int it = blockIdx.x; it < 1024; it += gridDim.x) {
    __syncthreads();
    const int i = it & 511, head = i >> 6, qb = i & 63;
    const long t0 = (long)qb * 256, kv0 = pass < 2 ? (long)(qb >> 3) * 2048 : 0;
    if (it < 512) {
      const int kvh = head >> 2;
      bf16* Q = (bf16*)(ws + OFF_QA) + t0 * 1024 + head * 128;
      attn_body<128, 1024, 256, 256, 2>(Q, (const bf16*)(ws + OFF_KA) + kv0 * 256 + kvh * 128, (const bf16*)(ws + OFF_VA) + kv0 * 256 + kvh * 128,
                                        (const bf16*)(ws + OFF_KAM) + kvh * 128, (const bf16*)(ws + OFF_VAM) + kvh * 128,
                                        Q, (const bf16*)(ws + OFF_GA) + t0 * 1024 + head * 128, NT, lds, wv);
    } else {
      bf16* O = (bf16*)(ws + OFF_HB) + ((long)pass * TP + t0) * 1024 + head * 128;
      attn_body<192, 1536, 1536, 1024, 1>((const bf16*)(ws + OFF_QB) + t0 * 1536 + head * 192, (const bf16*)(ws + OFF_KB) + kv0 * 1536 + head * 192,
                                          (const bf16*)(ws + OFF_VB) + kv0 * 1024 + head * 128, (const bf16*)(ws + OFF_KBM) + head * 192,
                                          (const bf16*)(ws + OFF_VBM) + head * 128, O, (const bf16*)(ws + OFF_GB) + t0 * 1024 + head * 128, NT, lds, wv);
    }
  }
}

DEV void p4_tile(const Params& p, int pass, int mt, int nt, char* lds, int wv) {
  char* ws = uni(p.ws);
  int tid = wv * 64 + lane_id(); asm volatile("" : "+v"(tid));
  const int lane = tid & 63, wid = __builtin_amdgcn_readfirstlane(tid >> 6), r32 = lane & 31, hi = lane >> 5;
  const int wm = wid >> 1, wn = wid & 1;
  f32x16 acc[2][4]; float dummy[2] = {0.f, 0.f};
#pragma unroll
  for (int a = 0; a < 2; ++a)
#pragma unroll
    for (int b = 0; b < 4; ++b) acc[a][b] = f32x16{};
  gemm_main<2, 4, 4, 2, false>(acc, dummy, (const bf16*)(ws + OFF_QA) + (long)mt * 256 * 1024, 1024,
                               (const bf16*)(ws + OFF_WPA) + (long)nt * 256 * 1024, 1024, 16, lds, tid);
#pragma unroll
  for (int mb = 0; mb < 2; ++mb) {
    const long tl = (long)mt * 256 + (wm * 2 + mb) * 32 + r32;
    const bf16* sa = (const bf16*)(ws + OFF_SA) + tl * 1024 + nt * 256 + wn * 128;
    const bf16* sb = (const bf16*)(ws + OFF_SB) + tl * 1024 + nt * 256 + wn * 128;
#pragma unroll
    for (int nb = 0; nb < 4; ++nb)
#pragma unroll
      for (int q = 0; q < 4; ++q) {
        float a0, a1, a2, a3, b0, b1, b2, b3; const int col = nb * 32 + 8 * q + 4 * hi;
        ld4(sa + col, a0, a1, a2, a3); ld4(sb + col, b0, b1, b2, b3);
        acc[mb][nb][4 * q] *= a0 / b0; acc[mb][nb][4 * q + 1] *= a1 / b1; acc[mb][nb][4 * q + 2] *= a2 / b2; acc[mb][nb][4 * q + 3] *= a3 / b3;
      }
  }
  gemm_main<2, 4, 4, 2, false>(acc, dummy, (const bf16*)(ws + OFF_HB) + ((long)pass * TP + mt * 256) * 1024, 1024,
                               (const bf16*)(ws + OFF_WPB) + (long)nt * 256 * 1024, 1024, 16, lds, tid);
#pragma unroll
  for (int mb = 0; mb < 2; ++mb) {
    const long tl = (long)mt * 256 + (wm * 2 + mb) * 32 + r32;
    const bf16* sb = (const bf16*)(ws + OFF_SB) + tl * 1024 + nt * 256 + wn * 128;
    bf16* md = (bf16*)(ws + OFF_MM) + tl * 1024 + nt * 256 + wn * 128;
#pragma unroll
    for (int nb = 0; nb < 4; ++nb)
#pragma unroll
      for (int q = 0; q < 4; ++q) {
        float b0, b1, b2, b3; const int col = nb * 32 + 8 * q + 4 * hi;
        ld4(sb + col, b0, b1, b2, b3);
        st4(md + col, acc[mb][nb][4 * q] * b0, acc[mb][nb][4 * q + 1] * b1, acc[mb][nb][4 * q + 2] * b2, acc[mb][nb][4 * q + 3] * b3);
      }
  }
}
DEV void p5_tile(const Params& p, int pass, int mt, int nt, char* lds, int wv) {
  char* ws = uni(p.ws);
  int tid = wv * 64 + lane_id(); asm volatile("" : "+v"(tid));
  const int lane = tid & 63, wid = __builtin_amdgcn_readfirstlane(tid >> 6), r32 = lane & 31, hi = lane >> 5;
  const int wm = wid >> 1, wn = wid & 1;
  f32x16 acc[2][4]; float dummy[2] = {0.f, 0.f};
#pragma unroll
  for (int a = 0; a < 2; ++a)
#pragma unroll
    for (int b = 0; b < 4; ++b) acc[a][b] = f32x16{};
  gemm_main<2, 4, 4, 2, false>(acc, dummy, (const bf16*)(ws + OFF_MM) + (long)mt * 256 * 1024, 1024,
                               (const bf16*)(ws + OFF_WO) + (long)nt * 256 * 1024, 1024, 16, lds, tid);
  constexpr int P5PITCH = 528;
  char* strip = lds + wid * (32 * P5PITCH);
#pragma unroll
  for (int mb = 0; mb < 2; ++mb) {
    const long g0 = (long)pass * TP + (long)mt * 256 + (wm * 2 + mb) * 32;
    const float* xs0 = (pass < 2 ? uni(p.x_prompt) + g0 * 1024 : uni(p.x_sample) + (g0 - 32768) * 1024) + nt * 256 + wn * 128;
    float* od0 = uni(p.out) + g0 * 1024 + nt * 256 + wn * 128;
#pragma unroll
    for (int nb = 0; nb < 4; ++nb)
#pragma unroll
      for (int q = 0; q < 4; ++q) {
        const f32x4 v = {acc[mb][nb][4 * q], acc[mb][nb][4 * q + 1], acc[mb][nb][4 * q + 2], acc[mb][nb][4 * q + 3]};
        *reinterpret_cast<LAS f32x4*>((LAS char*)(strip + r32 * P5PITCH + (nb * 32 + 8 * q + 4 * hi) * 4)) = v;
      }
#pragma unroll
    for (int i2 = 0; i2 < 16; ++i2) {
      const int row = i2 * 2 + (lane >> 5), ch = lane & 31;
      const f32x4 a = *reinterpret_cast<const LAS f32x4*>((const LAS char*)(strip + row * P5PITCH + ch * 16));
      f32x4 x = *reinterpret_cast<const f32x4*>(xs0 + (long)row * 1024 + ch * 4);
      x[0] += a[0]; x[1] += a[1]; x[2] += a[2]; x[3] += a[3];
      *reinterpret_cast<f32x4*>(od0 + (long)row * 1024 + ch * 4) = x;
    }
  }
}

#define XB_TMO      128
#define XB_XCNT(j)  (256  + 64 * (j))
#define XB_XSUB(j)  (1280 + 64 * (j))
#define XB_XGEN(j)  (2304 + 64 * (j))
#define XB_TOP      3328
#define XB_TOPGEN   3392
#define XB_SPIN_CAP (1u << 18)
DEV unsigned xb_ld(unsigned* p)              { return __hip_atomic_load(p, __ATOMIC_RELAXED, __HIP_MEMORY_SCOPE_AGENT); }
DEV unsigned xb_add(unsigned* p, unsigned v) { return __hip_atomic_fetch_add(p, v, __ATOMIC_RELAXED, __HIP_MEMORY_SCOPE_AGENT); }
DEV unsigned xb_xcc_id() { return (unsigned)__builtin_amdgcn_s_getreg((3 << 11) | 20) & 0xFu; }
#define XB_SPIN(cond, bar) do { unsigned _sp = 0; while (cond) { __builtin_amdgcn_s_sleep(1); \
    if ((++_sp & 255u) == 0u) { if (xb_ld(&(bar)[XB_TMO])) break; if (_sp > XB_SPIN_CAP) { atomicAdd(&(bar)[XB_TMO], 1u); break; } } } } while (0)
DEV void xcd_barrier_complete(unsigned* bar, unsigned x, unsigned& nloc, unsigned& nx) {
  const unsigned G = gridDim.x;
  unsigned sum, cnt, mine, sp = 0u;
  for (;;) {
    sum = 0u; cnt = 0u; mine = 0u;
#pragma unroll
    for (unsigned j = 0; j < 16; ++j) { const unsigned c = xb_ld(&bar[XB_XCNT(j)]); sum += c; cnt += (c > 0u) ? 1u : 0u; mine = (j == x) ? c : mine; }
    if (sum == G) break;
    __builtin_amdgcn_s_sleep(1);
    if ((++sp & 255u) == 0u) { if (xb_ld(&bar[XB_TMO])) break; if (sp > XB_SPIN_CAP) { atomicAdd(&bar[XB_TMO], 1u); break; } }
  }
  nloc = mine > 0u ? mine : 1u; nx = cnt > 0u ? cnt : 1u;
}
DEV void xcd_barrier(unsigned* bar, unsigned x, volatile LAS unsigned* st, int wv) {
  asm volatile("s_waitcnt vmcnt(0)" ::: "memory");
  __syncthreads();
  if (wv == 0 && lane_id() == 0) {
    __builtin_amdgcn_s_waitcnt(0);
    unsigned nloc = st[0], nx = st[1];
    if (nloc == 0u) { xcd_barrier_complete(bar, x, nloc, nx); st[0] = nloc; st[1] = nx; }
    const unsigned old = xb_add(&bar[XB_XSUB(x)], 1u);
    const unsigned gen = old / nloc;
    if (old + 1u == (gen + 1u) * nloc) {
      __builtin_amdgcn_fence(__ATOMIC_RELEASE, "agent");
      asm volatile("s_waitcnt vmcnt(0)" ::: "memory");
      const unsigned og = xb_add(&bar[XB_TOP], 1u);
      const unsigned tg = og / nx;
      if (og + 1u == (tg + 1u) * nx) xb_add(&bar[XB_TOPGEN], 1u);
      else XB_SPIN(xb_ld(&bar[XB_TOPGEN]) == tg, bar);
      __builtin_amdgcn_fence(__ATOMIC_ACQUIRE, "agent");
      xb_add(&bar[XB_XGEN(x)], 1u);
      asm volatile("s_waitcnt vmcnt(0)" ::: "memory");
    } else {
      XB_SPIN(xb_ld(&bar[XB_XGEN(x)]) == gen, bar);
      __builtin_amdgcn_fence(__ATOMIC_ACQUIRE, "agent");
      asm volatile("s_waitcnt vmcnt(0)" ::: "memory");
    }
  }
  __syncthreads();
}

__global__ void __launch_bounds__(NTHR) mega_fwd(Params p) {
  extern __shared__ __attribute__((aligned(16))) char lds[];
  cg::grid_group grid = cg::this_grid();
  const int wv = __builtin_amdgcn_readfirstlane((int)threadIdx.x >> 6);
#ifndef PHM
#define PHM 63
#endif
  volatile LAS unsigned* xst = (volatile LAS unsigned*)(lds + LDS_XB_OFF);
  const unsigned xcc = xb_xcc_id();
  if (wv == 0 && lane_id() == 0) { xst[0] = 0u; xst[1] = 0u; xst[2] = 0u; xst[3] = 0u; (void)xb_add(&((unsigned*)(uni(p.ws) + OFF_BAR))[XB_XCNT(xcc)], 1u); }
  __syncthreads();
#define GSYNC() xcd_barrier((unsigned*)(uni(p.ws) + OFF_BAR), xcc, xst, wv)
  if (PHM & 1) phase0(p, lds, wv);
  grid.sync();
  for (int pass = 0; pass < 3; ++pass) {
    if (PHM & 2) phase1(p, pass, lds, wv);
    GSYNC();
    if (PHM & 4) phase2(p, pass, lds, wv);
    GSYNC();
    if (PHM & 8) phase3(p, pass, lds, wv);
    GSYNC();
    if (PHM & 16) for (int t = vblock(); t < 256; t += gridDim.x) p4_tile(p, pass, (t >> 5) * 8 + (t & 7), (t >> 3) & 3, lds, wv);
    GSYNC();
    if (PHM & 32) for (int t = vblock(); t < 256; t += gridDim.x) p5_tile(p, pass, (t >> 5) * 8 + (t & 7), (t >> 3) & 3, lds, wv);
  }
#undef GSYNC
}

extern "C" void kernel_launch(void* const* d_in, const int* in_sizes, int n_in, void* d_out, int out_size, void* d_ws, size_t ws_size, hipStream_t stream) {
  static int grid_blocks = 0;
  if (grid_blocks == 0) {
    if (n_in != 17 || ws_size < WS_END || out_size != NREAL * DM) {
      fprintf(stderr, "kernel_launch: unexpected shapes: n_in %d out %d ws %zu (need %zu)\n", n_in, out_size, ws_size, (size_t)WS_END); grid_blocks = -1; return; }
    int dev = 0, cus = 0, per_cu = 0;
    (void)hipGetDevice(&dev);
    (void)hipDeviceGetAttribute(&cus, hipDeviceAttributeMultiprocessorCount, dev);
    if (hipFuncSetAttribute((const void*)mega_fwd, hipFuncAttributeMaxDynamicSharedMemorySize, LDS_BYTES) != hipSuccess) {
      fprintf(stderr, "kernel_launch: hipFuncSetAttribute failed\n"); grid_blocks = -1; return; }
    if (hipOccupancyMaxActiveBlocksPerMultiprocessor(&per_cu, (const void*)mega_fwd, NTHR, LDS_BYTES) != hipSuccess || per_cu < 1) {
      fprintf(stderr, "kernel_launch: occupancy query failed (%d)\n", per_cu); per_cu = 1; (void)hipGetLastError(); }
    grid_blocks = cus * per_cu;
  }
  if (grid_blocks < 0) return;
  Params p{};
  p.x_prompt = (const float*)d_in[0]; p.x_sample = (const float*)d_in[1]; p.meta = (const float*)d_in[2]; p.norm_gain = (const float*)d_in[3];
  p.w_in = (const float*)d_in[4]; p.b_merge = (const float*)d_in[5]; p.qna = (const float*)d_in[6]; p.kna = (const float*)d_in[7];
  p.cqn = (const float*)d_in[8]; p.ckvn = (const float*)d_in[9]; p.w_uq = (const float*)d_in[10]; p.w_ukv = (const float*)d_in[11];
  p.qnb = (const float*)d_in[12]; p.knb = (const float*)d_in[13]; p.wpa = (const float*)d_in[14]; p.wpb = (const float*)d_in[15]; p.wo = (const float*)d_in[16];
  p.out = (float*)d_out; p.ws = (char*)d_ws;
  if (hipMemsetAsync((char*)d_ws + OFF_BAR, 0, BAR_BYTES, stream) != hipSuccess) { fprintf(stderr, "kernel_launch: barrier memset failed\n"); return; }
  void* args[] = {&p};
  hipError_t e = hipLaunchCooperativeKernel((const void*)mega_fwd, dim3(grid_blocks), dim3(NTHR), args, LDS_BYTES, stream);
  if (e != hipSuccess) fprintf(stderr, "cooperative launch failed: %s (grid %d)\n", hipGetErrorString(e), grid_blocks);
}
```

```cpp
#include <hip/hip_runtime.h>
#include <hip/hip_bf16.h>
#include <hip/hip_cooperative_groups.h>
#include <cstdio>
#include <cstdint>
namespace cg = cooperative_groups;

using bf16 = __hip_bfloat16;
using bf16x8 = __attribute__((ext_vector_type(8))) short;
using s16x4  = __attribute__((ext_vector_type(4))) short;
using f32x16 = __attribute__((ext_vector_type(16))) float;
using f32x4  = __attribute__((ext_vector_type(4))) float;
using u32x4  = __attribute__((ext_vector_type(4))) unsigned;
using u32x2  = __attribute__((ext_vector_type(2))) unsigned;
#define DEV __device__ __forceinline__
#define SBAR() __builtin_amdgcn_sched_barrier(0)
#define LAS __attribute__((address_space(3)))

constexpr int DM = 1024;
constexpr int NREAL = 49152;
constexpr int TP = 16384;
constexpr int NHB = NREAL + 256;
constexpr int NCOL = 6400;
constexpr float EPS = 1e-6f;
constexpr float QSCALE_A = 0.088388347648318440f * 1.4426950408889634f;
constexpr float QSCALE_B = 0.072168783648703220f * 1.4426950408889634f;
constexpr int NTHR = 512;
constexpr int LDS_XB_OFF = 155648;
constexpr int LDS_BYTES = LDS_XB_OFF + 16;

constexpr size_t al256(size_t x) { return (x + 255) & ~(size_t)255; }
constexpr size_t OFF_WIN  = 0;
constexpr size_t OFF_WUQ  = OFF_WIN  + al256((size_t)NCOL * 1024 * 2);
constexpr size_t OFF_WUKV = OFF_WUQ  + al256((size_t)1536 * 384 * 2);
constexpr size_t OFF_WPA  = OFF_WUKV + al256((size_t)2048 * 256 * 2);
constexpr size_t OFF_WPB  = OFF_WPA  + al256((size_t)1024 * 1024 * 2);
constexpr size_t OFF_WO   = OFF_WPB  + al256((size_t)1024 * 1024 * 2);
constexpr size_t OFF_RAR  = OFF_WO   + al256((size_t)1024 * 1024 * 2);
constexpr size_t OFF_RAC  = OFF_RAR  + al256((size_t)257 * 32 * 8);
constexpr size_t OFF_RBR  = OFF_RAC  + al256((size_t)65 * 32 * 8);
constexpr size_t OFF_RBC  = OFF_RBR  + al256((size_t)257 * 16 * 8);
constexpr size_t OFF_RSTD = OFF_RBC  + al256((size_t)65 * 16 * 8);
constexpr size_t OFF_SMALL = OFF_RSTD + al256((size_t)NHB * 4);
constexpr size_t OFF_KAM  = OFF_SMALL + al256((size_t)2688 * 4);
constexpr size_t OFF_VAM  = OFF_KAM  + al256((size_t)64 * 256 * 2);
constexpr size_t OFF_KBM  = OFF_VAM  + al256((size_t)64 * 256 * 2);
constexpr size_t OFF_VBM  = OFF_KBM  + al256((size_t)64 * 1536 * 2);
constexpr size_t OFF_HB   = OFF_VBM  + al256((size_t)64 * 1024 * 2);
constexpr size_t OFF_QA   = OFF_HB   + al256((size_t)NHB * 1024 * 2);
constexpr size_t OFF_GA   = OFF_QA   + al256((size_t)TP * 1024 * 2);
constexpr size_t OFF_GB   = OFF_GA   + al256((size_t)TP * 1024 * 2);
constexpr size_t OFF_SA   = OFF_GB   + al256((size_t)TP * 1024 * 2);
constexpr size_t OFF_SB   = OFF_SA   + al256((size_t)TP * 1024 * 2);
constexpr size_t OFF_MM   = OFF_SB   + al256((size_t)TP * 1024 * 2);
constexpr size_t OFF_VB   = OFF_MM   + al256((size_t)TP * 1024 * 2);
constexpr size_t OFF_QB   = OFF_VB   + al256((size_t)TP * 1024 * 2);
constexpr size_t OFF_KB   = OFF_QB   + al256((size_t)TP * 1536 * 2);
constexpr size_t OFF_KA   = OFF_KB   + al256((size_t)TP * 1536 * 2);
constexpr size_t OFF_VA   = OFF_KA   + al256((size_t)TP * 256 * 2);
constexpr size_t OFF_CQ   = OFF_VA   + al256((size_t)TP * 256 * 2);
constexpr size_t OFF_CKV  = OFF_CQ   + al256((size_t)TP * 384 * 2);
constexpr size_t OFF_KR   = OFF_CKV  + al256((size_t)(TP + 256) * 256 * 2);
constexpr size_t OFF_BAR  = OFF_KR   + al256((size_t)(TP + 256) * 64 * 2);
constexpr size_t BAR_BYTES = 3456 * 4;
constexpr size_t WS_END   = OFF_BAR  + al256(BAR_BYTES);

struct Params {
  const float *x_prompt, *x_sample, *meta, *norm_gain, *w_in, *b_merge, *qna, *kna, *cqn, *ckvn, *w_uq, *w_ukv, *qnb, *knb, *wpa, *wpb, *wo;
  float* out; char* ws;
};

DEV int crow(int r, int hi) { return (r & 3) + 8 * (r >> 2) + 4 * hi; }
DEV unsigned cvtpk(float lo, float hi) { unsigned r; asm("v_cvt_pk_bf16_f32 %0, %1, %2" : "=v"(r) : "v"(lo), "v"(hi)); return r; }
DEV float bf2f(short s) { return __uint_as_float(((unsigned)(unsigned short)s) << 16); }
DEV void st4(bf16* p, float a, float b, float c, float d) { u32x2 w = {cvtpk(a, b), cvtpk(c, d)}; *reinterpret_cast<u32x2*>(p) = w; }
DEV void ld4(const bf16* p, float& a, float& b, float& c, float& d) {
  u32x2 w = *reinterpret_cast<const u32x2*>(p);
  a = __uint_as_float(w[0] << 16); b = __uint_as_float(w[0] & 0xffff0000u); c = __uint_as_float(w[1] << 16); d = __uint_as_float(w[1] & 0xffff0000u);
}
template <typename T> DEV T* uni(T* q) {
  const uint64_t v = (uint64_t)q; unsigned lo = (unsigned)v, hi = (unsigned)(v >> 32);
  asm volatile("" : "+s"(lo), "+s"(hi));
  return (T*)((__attribute__((address_space(1))) T*)(((uint64_t)hi << 32) | lo)); }
DEV int lane_id() { int l; asm volatile("v_mbcnt_lo_u32_b32 %0, -1, 0\n\tv_mbcnt_hi_u32_b32 %0, -1, %0" : "=v"(l)); return l; }
DEV float halfsum(float v) { auto rr = __builtin_amdgcn_permlane32_swap(__float_as_uint(v), __float_as_uint(v), false, false); return __uint_as_float(rr[0]) + __uint_as_float(rr[1]); }
DEV float silu_f(float x) { return x / (1.f + __expf(-x)); }
DEV float sigm_f(float x) { return 1.f / (1.f + __expf(-x)); }

template <int MB, int NB, int WM, int WN, bool SSQ>
DEV void gemm_main(f32x16 (&acc)[MB][NB], float (&ssq)[MB], const bf16* __restrict__ A, int lda,
                   const bf16* __restrict__ W, int ldw, int KT, char* lds, int tid) {
  constexpr int BN = WN * NB * 32; constexpr int NCW = BN / 64;
  const int lane = tid & 63, wid = __builtin_amdgcn_readfirstlane(tid >> 6), r32 = lane & 31, hi = lane >> 5;
  const int wm = wid / WN, wn = wid % WN;
  const int srow = tid >> 3, sslot = tid & 7;
  const unsigned aoff = (unsigned)(srow * lda + sslot * 8) * 2u, woffg = (unsigned)(srow * ldw + sslot * 8) * 2u;
  const int woff = srow * 128 + ((sslot ^ ((srow >> 1) & 7)) << 4);
  bf16x8 sa[4], sw[NCW];
#define GLOAD(kt_) do { _Pragma("unroll") for (int i = 0; i < 4; ++i) sa[i] = *reinterpret_cast<const bf16x8*>((const char*)(A + (long)i * 64 * lda + (kt_) * 64) + aoff); \
    _Pragma("unroll") for (int i = 0; i < NCW; ++i) sw[i] = *reinterpret_cast<const bf16x8*>((const char*)(W + (long)i * 64 * ldw + (kt_) * 64) + woffg); } while (0)
#define LWRITE(b_) do { char* d_ = lds + (b_) * 65536 + woff; \
    _Pragma("unroll") for (int i = 0; i < 4; ++i) *reinterpret_cast<bf16x8*>(d_ + i * 8192) = sa[i]; \
    _Pragma("unroll") for (int i = 0; i < NCW; ++i) *reinterpret_cast<bf16x8*>(d_ + 32768 + i * 8192) = sw[i]; } while (0)
#define LOADF(AF, WF, cb_, ks_) do { const int so = (((ks_) * 2 + hi) ^ swz) << 4; \
    _Pragma("unroll") for (int mb = 0; mb < MB; ++mb) AF[mb] = *reinterpret_cast<const bf16x8*>((cb_) + abase + mb * 4096 + so); \
    _Pragma("unroll") for (int nb = 0; nb < NB; ++nb) WF[nb] = *reinterpret_cast<const bf16x8*>((cb_) + 32768 + wbase + nb * 4096 + so); } while (0)
#define MMA(AF, WF) do { _Pragma("unroll") for (int mb = 0; mb < MB; ++mb) _Pragma("unroll") for (int nb = 0; nb < NB; ++nb) \
      acc[mb][nb] = __builtin_amdgcn_mfma_f32_32x32x16_bf16(WF[nb], AF[mb], acc[mb][nb], 0, 0, 0); } while (0)
  const int swz = (r32 >> 1) & 7;
  const int abase = (wm * MB * 32 + r32) * 128, wbase = (wn * NB * 32 + r32) * 128;
  bf16x8 af0[MB], wf0[NB], af1[MB], wf1[NB];
  GLOAD(0);
  __syncthreads();
  LWRITE(0);
  if (KT > 1) GLOAD(1);
  __syncthreads();
  LOADF(af0, wf0, lds, 0);
  for (int kt = 0; kt < KT; ++kt) {
    const char* cb = lds + (kt & 1) * 65536; const char* nb_ = lds + ((kt + 1) & 1) * 65536;
    LOADF(af1, wf1, cb, 1); SBAR(); MMA(af0, wf0); SBAR();
    LOADF(af0, wf0, cb, 2); SBAR(); MMA(af1, wf1); SBAR();
    if (kt + 1 < KT) LWRITE((kt + 1) & 1);
    if (kt + 2 < KT) GLOAD(kt + 2);
    SBAR();
    LOADF(af1, wf1, cb, 3); SBAR(); MMA(af0, wf0); SBAR();
    __syncthreads();
    if (kt + 1 < KT) LOADF(af0, wf0, nb_, 0);
    SBAR(); MMA(af1, wf1); SBAR();
  }
  __syncthreads();
#undef GLOAD
#undef LWRITE
#undef LOADF
#undef MMA
}

DEV void prep_tr_tile(const float* __restrict__ src, int K, int N, bf16* __restrict__ dst, const float* __restrict__ gain,
                      int kt, int ct, int rowshift, char* lds, int wv) {
  float* T = reinterpret_cast<float*>(lds);
  int tid = wv * 64 + lane_id(); asm volatile("" : "+v"(tid));
  { const int i = tid >> 3, j0 = (tid & 7) * 8;
    const float* s = src + (long)(kt * 64 + i) * N + ct * 64 + j0;
    f32x4 a = *reinterpret_cast<const f32x4*>(s), b = *reinterpret_cast<const f32x4*>(s + 4);
    float g = gain ? gain[kt * 64 + i] : 1.f;
    float* t = T + i * 65 + j0;
    t[0] = a[0] * g; t[1] = a[1] * g; t[2] = a[2] * g; t[3] = a[3] * g; t[4] = b[0] * g; t[5] = b[1] * g; t[6] = b[2] * g; t[7] = b[3] * g; }
  __syncthreads();
  { const int jj = tid >> 3, i0 = (tid & 7) * 8;
    u32x4 w;
    w[0] = cvtpk(T[(i0 + 0) * 65 + jj], T[(i0 + 1) * 65 + jj]); w[1] = cvtpk(T[(i0 + 2) * 65 + jj], T[(i0 + 3) * 65 + jj]);
    w[2] = cvtpk(T[(i0 + 4) * 65 + jj], T[(i0 + 5) * 65 + jj]); w[3] = cvtpk(T[(i0 + 6) * 65 + jj], T[(i0 + 7) * 65 + jj]);
    *reinterpret_cast<u32x4*>(dst + (long)(ct * 64 + jj + rowshift) * K + kt * 64 + i0) = w; }
  __syncthreads();
}

DEV void phase0(const Params& p, char* lds, int wv) {
  char* ws = uni(p.ws);
  int tid = wv * 64 + lane_id(); asm volatile("" : "+v"(tid));
  const int bid = blockIdx.x, G = gridDim.x;
  constexpr int T_WIN = 16 * 99, T_WUQ = 6 * 24, T_WUKV = 4 * 32, T_P = 16 * 16;
  constexpr int T_ALL = T_WIN + T_WUQ + T_WUKV + 3 * T_P;
  for (int t = bid; t < T_ALL; t += G) {
    int u = t;
    if (u < T_WIN) { int ct = u % 99, kt = u / 99; prep_tr_tile(uni(p.w_in), 1024, 6336, (bf16*)(ws + OFF_WIN), uni(p.norm_gain), kt, ct, ct > 50 ? 64 : 0, lds, wv); continue; }
    u -= T_WIN;
    if (u < T_WUQ) { int ct = u % 24, kt = u / 24; prep_tr_tile(uni(p.w_uq), 384, 1536, (bf16*)(ws + OFF_WUQ), uni(p.cqn), kt, ct, 0, lds, wv); continue; }
    u -= T_WUQ;
    if (u < T_WUKV) { int ct = u % 32, kt = u / 32; prep_tr_tile(uni(p.w_ukv), 256, 2048, (bf16*)(ws + OFF_WUKV), uni(p.ckvn), kt, ct, 0, lds, wv); continue; }
    u -= T_WUKV;
    { int which = u / T_P, v = u % T_P, ct = v % 16, kt = v / 16;
      const float* src = which == 0 ? uni(p.wpa) : (which == 1 ? uni(p.wpb) : uni(p.wo));
      bf16* dst = (bf16*)(ws + (which == 0 ? OFF_WPA : (which == 1 ? OFF_WPB : OFF_WO)));
      prep_tr_tile(src, 1024, 1024, dst, nullptr, kt, ct, 0, lds, wv); }
  }
  const int gt = bid * NTHR + tid, GT = G * NTHR;
  for (int i = gt; i < 64 * 1024 / 8; i += GT) reinterpret_cast<u32x4*>(ws + OFF_WIN + (size_t)3264 * 1024 * 2)[i] = u32x4{0, 0, 0, 0};
  for (int i = gt; i < (int)((OFF_HB - OFF_KAM) / 16); i += GT) reinterpret_cast<u32x4*>(ws + OFF_KAM)[i] = u32x4{0, 0, 0, 0};
  { float* sm = (float*)(ws + OFF_SMALL);
    for (int i = gt; i < 2688; i += GT) {
      float v;
      if (i < 2048) v = uni(p.b_merge)[i]; else if (i < 2176) v = uni(p.qna)[i - 2048]; else if (i < 2304) v = uni(p.kna)[i - 2176];
      else if (i < 2496) v = uni(p.qnb)[i - 2304]; else v = uni(p.knb)[i - 2496];
      sm[i] = v; } }
  {
    float2* rar = (float2*)(ws + OFF_RAR); float2* rac = (float2*)(ws + OFF_RAC); float2* rbr = (float2*)(ws + OFF_RBR); float2* rbc = (float2*)(ws + OFF_RBC);
    constexpr int N1 = 257 * 32, N2 = 65 * 32, N3 = 257 * 16, N4 = 65 * 16;
    for (int i = gt; i < N1 + N2 + N3 + N4; i += GT) {
      int u = i; float2* dst; int pos, f, nf, ident;
      if (u < N1) { dst = rar + u; pos = u / 32; f = u % 32; nf = 32; ident = 256; }
      else if ((u -= N1) < N2) { dst = rac + u; pos = u / 32; f = u % 32; nf = 32; ident = 64; }
      else if ((u -= N2) < N3) { dst = rbr + u; pos = u / 16; f = u % 16; nf = 16; ident = 256; }
      else { u -= N3; dst = rbc + u; pos = u / 16; f = u % 16; nf = 16; ident = 64; }
      float c = 1.f, s = 0.f;
      if (pos != ident) {
        float invf = exp2f(-13.287712379549449f * (float)f / (float)nf);
        float ang = (float)pos * invf;
        double rv = (double)ang * 0.15915494309189535; rv -= rint(rv);
        float rf = (float)rv;
        c = __builtin_amdgcn_cosf(rf); s = __builtin_amdgcn_sinf(rf);
      }
      *dst = make_float2(c, s);
    }
  }
  {
    const int lane = tid & 63, gw = bid * 8 + (tid >> 6), GW = G * 8;
    bf16* HB = (bf16*)(ws + OFF_HB); float* RS = (float*)(ws + OFF_RSTD);
    for (int row0 = gw; row0 < NHB; row0 += 2 * GW) {
      f32x4 v[2][4]; float ss[2] = {0.f, 0.f}; bool has[2];
#pragma unroll
      for (int u = 0; u < 2; ++u) {
        const int row = row0 + u * GW;
        const float* src = nullptr;
        if (row < 32768) src = uni(p.x_prompt) + (long)row * 1024;
        else if (row < NREAL) src = uni(p.x_sample) + (long)(row - 32768) * 1024;
        else if (row < NREAL + 16) src = uni(p.meta) + (long)(row - NREAL) * 1024;
        has[u] = (src != nullptr);
#pragma unroll
        for (int j = 0; j < 4; ++j) v[u][j] = src ? *reinterpret_cast<const f32x4*>(src + j * 256 + lane * 4) : f32x4{0, 0, 0, 0};
      }
#pragma unroll
      for (int u = 0; u < 2; ++u) {
        const int row = row0 + u * GW;
#pragma unroll
        for (int j = 0; j < 4; ++j) ss[u] += v[u][j][0] * v[u][j][0] + v[u][j][1] * v[u][j][1] + v[u][j][2] * v[u][j][2] + v[u][j][3] * v[u][j][3];
#pragma unroll
        for (int o = 1; o < 64; o <<= 1) ss[u] += __uint_as_float(__builtin_amdgcn_ds_bpermute((lane ^ o) << 2, __float_as_uint(ss[u])));
        if (row < NHB) {
#pragma unroll
          for (int j = 0; j < 4; ++j) st4(HB + (long)row * 1024 + j * 256 + lane * 4, v[u][j][0], v[u][j][1], v[u][j][2], v[u][j][3]);
          if (lane == 0) RS[row] = has[u] ? rsqrtf(ss[u] * (1.f / 1024.f) + EPS) : 0.f;
        }
      }
    }
  }
}

template <int MODE, int NBLK>
DEV void store_plain(const f32x16* a, float rstd, bf16* dst, const float* bias, int hi) {
#pragma unroll
  for (int nb = 0; nb < NBLK; ++nb)
#pragma unroll
    for (int q = 0; q < 4; ++q) {
      const int col = nb * 32 + 8 * q + 4 * hi;
      float v0 = a[nb][4 * q] * rstd, v1 = a[nb][4 * q + 1] * rstd, v2 = a[nb][4 * q + 2] * rstd, v3 = a[nb][4 * q + 3] * rstd;
      if constexpr (MODE == 1) { v0 = silu_f(v0); v1 = silu_f(v1); v2 = silu_f(v2); v3 = silu_f(v3); }
      if constexpr (MODE == 2) { f32x4 b = *reinterpret_cast<const f32x4*>(bias + col);
        v0 = sigm_f(v0 + b[0]); v1 = sigm_f(v1 + b[1]); v2 = sigm_f(v2 + b[2]); v3 = sigm_f(v3 + b[3]); }
      st4(dst + col, v0, v1, v2, v3);
    }
}
DEV void rope_pair32(f32x16& y1, f32x16& y2, const float2* tab, int hi) {
#pragma unroll
  for (int q = 0; q < 4; ++q) {
    const f32x4 t0 = *reinterpret_cast<const f32x4*>(tab + 8 * q + 4 * hi), t1 = *reinterpret_cast<const f32x4*>(tab + 8 * q + 4 * hi + 2);
    const float cs[4] = {t0[0], t0[2], t1[0], t1[2]}, sn[4] = {t0[1], t0[3], t1[1], t1[3]};
#pragma unroll
    for (int j = 0; j < 4; ++j) { const int r = 4 * q + j; float a = y1[r], b = y2[r]; y1[r] = a * cs[j] - b * sn[j]; y2[r] = a * sn[j] + b * cs[j]; }
  }
}
DEV void rope_in32(f32x16& y, const float2* tab, int hi) {
#pragma unroll
  for (int q = 0; q < 2; ++q) {
    const f32x4 t0 = *reinterpret_cast<const f32x4*>(tab + 8 * q + 4 * hi), t1 = *reinterpret_cast<const f32x4*>(tab + 8 * q + 4 * hi + 2);
    const float cs[4] = {t0[0], t0[2], t1[0], t1[2]}, sn[4] = {t0[1], t0[3], t1[1], t1[3]};
#pragma unroll
    for (int j = 0; j < 4; ++j) { const int r = 4 * q + j; float a = y[r], b = y[r + 8]; y[r] = a * cs[j] - b * sn[j]; y[r + 8] = a * sn[j] + b * cs[j]; }
  }
}
DEV void scale_gain(f32x16& y, float s, const float* gain, int hi) {
#pragma unroll
  for (int q = 0; q < 4; ++q) { const f32x4 g = *reinterpret_cast<const f32x4*>(gain + 8 * q + 4 * hi);
#pragma unroll
    for (int j = 0; j < 4; ++j) y[4 * q + j] *= s * g[j]; }
}
DEV float sumsq(const f32x16& y) { float s = 0.f;
#pragma unroll
  for (int r = 0; r < 16; ++r) s = fmaf(y[r], y[r], s);
  return s; }
DEV void store_blk(const f32x16& y, bf16* dst, int hi) {
#pragma unroll
  for (int q = 0; q < 4; ++q) st4(dst + 8 * q + 4 * hi, y[4 * q], y[4 * q + 1], y[4 * q + 2], y[4 * q + 3]);
}

template <int NEL> DEV float row_ssq(const bf16* row, int hi) {
  float s = 0.f;
#pragma unroll
  for (int c = 0; c < NEL / 16; ++c) { const bf16x8 v = *reinterpret_cast<const bf16x8*>(row + (2 * c + hi) * 8);
#pragma unroll
    for (int e = 0; e < 8; ++e) { const float f = bf2f(v[e]); s = fmaf(f, f, s); } }
  return halfsum(s);
}
constexpr int SPITCH = 272;
DEV void lst4(char* p, float a, float b, float c, float d) { u32x2 w = {cvtpk(a, b), cvtpk(c, d)}; *reinterpret_cast<LAS u32x2*>((LAS char*)p) = w; }
template <int MODE, int NBLK>
DEV void store_plain_l(const f32x16* a, float rstd, char* srow, const float* bias, int hi) {
#pragma unroll
  for (int nb = 0; nb < NBLK; ++nb)
#pragma unroll
    for (int q = 0; q < 4; ++q) {
      const int col = nb * 32 + 8 * q + 4 * hi;
      float v0 = a[nb][4 * q] * rstd, v1 = a[nb][4 * q + 1] * rstd, v2 = a[nb][4 * q + 2] * rstd, v3 = a[nb][4 * q + 3] * rstd;
      if constexpr (MODE == 1) { v0 = silu_f(v0); v1 = silu_f(v1); v2 = silu_f(v2); v3 = silu_f(v3); }
      if constexpr (MODE == 2) { f32x4 b = *reinterpret_cast<const f32x4*>(bias + col);
        v0 = sigm_f(v0 + b[0]); v1 = sigm_f(v1 + b[1]); v2 = sigm_f(v2 + b[2]); v3 = sigm_f(v3 + b[3]); }
      lst4(srow + col * 2, v0, v1, v2, v3);
    }
}
DEV void store_blk_l(const f32x16& y, char* sp, int hi) {
#pragma unroll
  for (int q = 0; q < 4; ++q) lst4(sp + (8 * q + 4 * hi) * 2, y[4 * q], y[4 * q + 1], y[4 * q + 2], y[4 * q + 3]);
}
template <int NCOLS> DEV void flush_strip(const char* strip, bf16* gbase, long ld, int nrows, int lane) {
  constexpr int CP = NCOLS / 8, RPI = 64 / CP, NI = 32 / RPI;
  const int rr = lane / CP, ch = lane % CP;
#pragma unroll
  for (int i = 0; i < NI; ++i) { const int row = i * RPI + rr;
    const u32x4 v = *reinterpret_cast<const LAS u32x4*>((const LAS char*)(strip + row * SPITCH + ch * 16));
    if (row < nrows) *reinterpret_cast<u32x4*>(gbase + (long)row * ld + ch * 8) = v; }
}
DEV void p1_tile(const Params& p, int pass, int mt, int nt, char* lds, int wv) {
  char* ws = uni(p.ws);
  int tid = wv * 64 + lane_id(); asm volatile("" : "+v"(tid));
  const int lane = tid & 63, wid = __builtin_amdgcn_readfirstlane(tid >> 6), r32 = lane & 31, hi = lane >> 5;
  const int wm = wid >> 1, wn = wid & 1;
  const bool meta = (mt == 64);
  const long hb0 = meta ? (long)NREAL : (long)pass * TP + mt * 256;
  const bf16* A = (const bf16*)(ws + OFF_HB) + hb0 * 1024;
  const bf16* W = (const bf16*)(ws + OFF_WIN) + (long)nt * 256 * 1024;
  f32x16 acc[2][4]; float dummy[2] = {0.f, 0.f};
#pragma unroll
  for (int a = 0; a < 2; ++a)
#pragma unroll
    for (int b = 0; b < 4; ++b) acc[a][b] = f32x16{};
  gemm_main<2, 4, 4, 2, false>(acc, dummy, A, 1024, W, 1024, 16, lds, tid);
  const int seg = nt * 2 + wn;
  const float* RS = (const float*)(ws + OFF_RSTD);
  char* strip = lds + wid * (32 * SPITCH);
  char* srow = strip + r32 * SPITCH;
#pragma unroll
  for (int mb = 0; mb < 2; ++mb) {
    const int row0 = (wm * 2 + mb) * 32;
    const int rl = row0 + r32;
    const int tl = mt * 256 + rl;
    const long tl0 = (long)mt * 256 + row0;
    const int nrows = meta ? (row0 == 0 ? 16 : 0) : 32;
    const float rstd = RS[hb0 + rl];
    const int pos = (pass < 2) ? (tl & 2047) : tl;
    const int ridx = meta ? 256 : (pos >> 6), cidx = meta ? 64 : (pos & 63);
    f32x16* a = acc[mb];
    if (seg < 10) {
      const bool isq = seg < 8;
      if (isq && meta) continue;
      float ss = halfsum(sumsq(a[0]) + sumsq(a[1]) + sumsq(a[2]) + sumsq(a[3])) * rstd * rstd;
      const float rn = rsqrtf(ss * (1.f / 128.f) + EPS) * rstd * (isq ? QSCALE_A : 1.f);
      const float* gain = isq ? ((const float*)(ws + OFF_SMALL) + 2048) : ((const float*)(ws + OFF_SMALL) + 2176);
      SBAR();
      scale_gain(a[0], rn, gain, hi); scale_gain(a[1], rn, gain + 32, hi);
      rope_pair32(a[0], a[1], (const float2*)(ws + OFF_RAR) + ridx * 32, hi);
      store_blk_l(a[0], srow, hi); store_blk_l(a[1], srow + 64, hi);
      SBAR();
      scale_gain(a[2], rn, gain + 64, hi); scale_gain(a[3], rn, gain + 96, hi);
      rope_pair32(a[2], a[3], (const float2*)(ws + OFF_RAC) + cidx * 32, hi);
      store_blk_l(a[2], srow + 128, hi); store_blk_l(a[3], srow + 192, hi);
      SBAR();
      if (isq) flush_strip<128>(strip, (bf16*)(ws + OFF_QA) + tl0 * 1024 + seg * 128, 1024, nrows, lane);
      else if (!meta) flush_strip<128>(strip, (bf16*)(ws + OFF_KA) + tl0 * 256 + (seg - 8) * 128, 256, nrows, lane);
      else flush_strip<128>(strip, (bf16*)(ws + OFF_KAM) + (long)row0 * 256 + (seg - 8) * 128, 256, nrows, lane);
    } else if (seg < 12) {
      store_plain_l<0, 4>(a, rstd, srow, nullptr, hi);
      if (!meta) flush_strip<128>(strip, (bf16*)(ws + OFF_VA) + tl0 * 256 + (seg - 10) * 128, 256, nrows, lane);
      else flush_strip<128>(strip, (bf16*)(ws + OFF_VAM) + (long)row0 * 256 + (seg - 10) * 128, 256, nrows, lane);
    } else if (seg < 20) {
      if (!meta) { store_plain_l<1, 4>(a, rstd, srow, nullptr, hi); flush_strip<128>(strip, (bf16*)(ws + OFF_GA) + tl0 * 1024 + (seg - 12) * 128, 1024, 32, lane); }
    } else if (seg < 23) {
      if (!meta) { store_plain_l<0, 4>(a, rstd, srow, nullptr, hi); flush_strip<128>(strip, (bf16*)(ws + OFF_CQ) + tl0 * 384 + (seg - 20) * 128, 384, 32, lane); }
    } else if (seg < 25) {
      const long r0 = meta ? (long)TP + row0 : tl0;
      store_plain_l<0, 4>(a, rstd, srow, nullptr, hi); flush_strip<128>(strip, (bf16*)(ws + OFF_CKV) + r0 * 256 + (seg - 23) * 128, 256, 32, lane);
    } else if (seg == 25) {
      const long r0 = meta ? (long)TP + row0 : tl0;
      store_plain_l<0, 2>(a, rstd, srow, nullptr, hi); flush_strip<64>(strip, (bf16*)(ws + OFF_KR) + r0 * 64, 64, 32, lane);
    } else if (seg < 34) {
      if (!meta) { store_plain_l<1, 4>(a, rstd, srow, nullptr, hi); flush_strip<128>(strip, (bf16*)(ws + OFF_GB) + tl0 * 1024 + (seg - 26) * 128, 1024, 32, lane); }
    } else if (seg < 42) {
      if (!meta) { store_plain_l<2, 4>(a, rstd, srow, ((const float*)(ws + OFF_SMALL)) + (seg - 34) * 128, hi); flush_strip<128>(strip, (bf16*)(ws + OFF_SA) + tl0 * 1024 + (seg - 34) * 128, 1024, 32, lane); }
    } else {
      if (!meta) { store_plain_l<2, 4>(a, rstd, srow, ((const float*)(ws + OFF_SMALL)) + 1024 + (seg - 42) * 128, hi); flush_strip<128>(strip, (bf16*)(ws + OFF_SB) + tl0 * 1024 + (seg - 42) * 128, 1024, 32, lane); }
    }
  }
}
DEV int vblock() { const int G = gridDim.x, b = blockIdx.x; return (G % 8 == 0) ? (b % 8) * (G / 8) + b / 8 : b; }
DEV void phase1(const Params& p, int pass, char* lds, int wv) {
  const int G = gridDim.x;
  if (G == 256) {
    const int v = vblock(), x = v >> 5, sl = v & 31;
    for (int j = sl; j < 200; j += 32) p1_tile(p, pass, 8 * x + (j & 7), j >> 3, lds, wv);
    if (pass == 0 && sl == 31 && x < 4) p1_tile(p, pass, 64, x == 0 ? 4 : (x == 1 ? 5 : (x == 2 ? 11 : 12)), lds, wv);
    return;
  }
  const int nt_real = 64 * 25;
  const int ntiles = nt_real + (pass == 0 ? 4 : 0);
  for (int t = blockIdx.x; t < ntiles; t += gridDim.x) {
    if (t < nt_real) p1_tile(p, pass, t / 25, t % 25, lds, wv);
    else { const int k = t - nt_real; p1_tile(p, pass, 64, k == 0 ? 4 : (k == 1 ? 5 : (k == 2 ? 11 : 12)), lds, wv); }
  }
}

DEV void p2_uq_tile(const Params& p, int pass, int mt, int head, char* lds, int wv) {
  char* ws = uni(p.ws);
  int tid = wv * 64 + lane_id(); asm volatile("" : "+v"(tid));
  const int lane = tid & 63, wid = __builtin_amdgcn_readfirstlane(tid >> 6), r32 = lane & 31, hi = lane >> 5;
  const bf16* A = (const bf16*)(ws + OFF_CQ) + (long)mt * 256 * 384;
  const bf16* W = (const bf16*)(ws + OFF_WUQ) + (long)head * 192 * 384;
  f32x16 acc[1][6]; float ssq[1] = {0.f};
#pragma unroll
  for (int b = 0; b < 6; ++b) acc[0][b] = f32x16{};
  gemm_main<1, 6, 8, 1, false>(acc, ssq, A, 384, W, 384, 6, lds, tid);
  const int rl = wid * 32 + r32, tl = mt * 256 + rl;
  const float rstd = rsqrtf(row_ssq<384>(A + (long)rl * 384, hi) * (1.f / 384.f) + EPS);
  SBAR();
  f32x16* a = acc[0];
  float ss = 0.f;
#pragma unroll
  for (int nb = 0; nb < 6; ++nb) ss += sumsq(a[nb]);
  ss = halfsum(ss) * rstd * rstd;
  const float rn = rsqrtf(ss * (1.f / 192.f) + EPS) * rstd * QSCALE_B;
  const int pos = (pass < 2) ? (tl & 2047) : tl;
  bf16* dst = (bf16*)(ws + OFF_QB) + (long)tl * 1536 + head * 192;
#pragma unroll
  for (int nb = 0; nb < 4; ++nb) { SBAR(); scale_gain(a[nb], rn, ((const float*)(ws + OFF_SMALL) + 2304) + nb * 32, hi); store_blk(a[nb], dst + nb * 32, hi); }
  SBAR();
  scale_gain(a[4], rn, ((const float*)(ws + OFF_SMALL) + 2304) + 128, hi);
  rope_in32(a[4], (const float2*)(ws + OFF_RBR) + (pos >> 6) * 16, hi);
  store_blk(a[4], dst + 128, hi);
  SBAR();
  scale_gain(a[5], rn, ((const float*)(ws + OFF_SMALL) + 2304) + 160, hi);
  rope_in32(a[5], (const float2*)(ws + OFF_RBC) + (pos & 63) * 16, hi);
  store_blk(a[5], dst + 160, hi);
  SBAR();
}
DEV void p2_ukv_tile(const Params& p, int pass, int mt, int head, char* lds, int wv) {
  char* ws = uni(p.ws);
  int tid = wv * 64 + lane_id(); asm volatile("" : "+v"(tid));
  const int lane = tid & 63, wid = __builtin_amdgcn_readfirstlane(tid >> 6), r32 = lane & 31, hi = lane >> 5;
  const int wm = wid >> 1, wn = wid & 1;
  const bool meta = (mt == 64);
  const bf16* A = (const bf16*)(ws + OFF_CKV) + (long)mt * 256 * 256;
  const bf16* W = (const bf16*)(ws + OFF_WUKV) + (long)head * 256 * 256;
  float rstdv[2];
#pragma unroll
  for (int mb = 0; mb < 2; ++mb) rstdv[mb] = rsqrtf(row_ssq<256>(A + (long)((wm * 2 + mb) * 32 + r32) * 256, hi) * (1.f / 256.f) + EPS);
  SBAR();
  f32x16 acc[2][4]; float ssq[2] = {0.f, 0.f};
#pragma unroll
  for (int a = 0; a < 2; ++a)
#pragma unroll
    for (int b = 0; b < 4; ++b) acc[a][b] = f32x16{};
  gemm_main<2, 4, 4, 2, false>(acc, ssq, A, 256, W, 256, 4, lds, tid);
  if (wn == 1) {
#pragma unroll
    for (int mb = 0; mb < 2; ++mb) {
      const int rl = (wm * 2 + mb) * 32 + r32, tl = mt * 256 + rl;
      bf16* vd = meta ? (bf16*)(ws + OFF_VBM) + (long)rl * 1024 + head * 128 : (bf16*)(ws + OFF_VB) + (long)tl * 1024 + head * 128;
      if (!meta || rl < 16) store_plain<0, 4>(acc[mb], rstdv[mb], vd, nullptr, hi);
      SBAR();
    }
    return;
  }
#pragma unroll
  for (int mb = 0; mb < 2; ++mb) {
    const int rl = (wm * 2 + mb) * 32 + r32, tl = mt * 256 + rl;
    const float rstd = rstdv[mb];
    f32x16* a = acc[mb];
    const bool dost = (!meta || rl < 16);
    const bf16* krp = (const bf16*)(ws + OFF_KR) + (long)tl * 64;
    float ss = 0.f;
#pragma unroll
    for (int nb = 0; nb < 4; ++nb) ss += sumsq(a[nb]);
    ss *= rstd * rstd;
#pragma unroll
    for (int q = 0; q < 8; ++q) { float t0, t1, t2, t3; ld4(krp + 8 * q + 4 * hi, t0, t1, t2, t3); ss += t0 * t0 + t1 * t1 + t2 * t2 + t3 * t3; }
    ss = halfsum(ss);
    const float rn0 = rsqrtf(ss * (1.f / 192.f) + EPS), rn = rn0 * rstd;
    const int pos = (pass < 2) ? (tl & 2047) : tl;
    const int ridx = meta ? 256 : (pos >> 6), cidx = meta ? 64 : (pos & 63);
    bf16* kd = meta ? (bf16*)(ws + OFF_KBM) + (long)rl * 1536 + head * 192 : (bf16*)(ws + OFF_KB) + (long)tl * 1536 + head * 192;
#pragma unroll
    for (int nb = 0; nb < 4; ++nb) { SBAR(); scale_gain(a[nb], rn, ((const float*)(ws + OFF_SMALL) + 2496) + nb * 32, hi); if (dost) store_blk(a[nb], kd + nb * 32, hi); }
    SBAR();
#pragma unroll
    for (int h2 = 0; h2 < 2; ++h2) {
      f32x16 kr;
#pragma unroll
      for (int q = 0; q < 4; ++q) { float t0, t1, t2, t3; ld4(krp + h2 * 32 + 8 * q + 4 * hi, t0, t1, t2, t3); kr[4 * q] = t0; kr[4 * q + 1] = t1; kr[4 * q + 2] = t2; kr[4 * q + 3] = t3; }
      scale_gain(kr, rn0, ((const float*)(ws + OFF_SMALL) + 2496) + 128 + h2 * 32, hi);
      rope_in32(kr, (const float2*)(ws + (h2 == 0 ? OFF_RBR : OFF_RBC)) + (h2 == 0 ? ridx : cidx) * 16, hi);
      if (dost) store_blk(kr, kd + 128 + h2 * 32, hi);
      SBAR();
    }
  }
}
DEV void phase2(const Params& p, int pass, char* lds, int wv) {
  const int G = gridDim.x;
  if (G == 256) {
    const int v = vblock(), x = v >> 5, sl = v & 31;
    for (int j = sl; j < 128; j += 32) {
      const int mt = 8 * x + (j & 7), head = (j >> 3) & 7;
      if (j < 64) p2_ukv_tile(p, pass, mt, head, lds, wv); else p2_uq_tile(p, pass, mt, head, lds, wv);
    }
    if (pass == 0 && sl == 0) p2_ukv_tile(p, pass, 64, x, lds, wv);
    return;
  }
  const int n_kv = (64 + (pass == 0 ? 1 : 0)) * 8, n_q = 64 * 8;
  for (int t = blockIdx.x; t < n_kv + n_q; t += gridDim.x) {
    if (t < n_kv) p2_ukv_tile(p, pass, t >> 3, t & 7, lds, wv);
    else { const int u = t - n_kv; p2_uq_tile(p, pass, u >> 3, u & 7, lds, wv); }
  }
}

constexpr int KVBLK = 64;
constexpr float THR = 8.f;
template <int DQK> struct AC {
  static constexpr float SCALE = DQK == 128 ? 0.088388347648318440f : 0.072168783648703220f;
  static constexpr float C = SCALE * 1.4426950408889634f;
  static constexpr int KPITCH = DQK * 2 + 16;
  static constexpr int SHM_K = KVBLK * KPITCH;
};
DEV void partialSM(f32x16& p0) {
#pragma unroll
  for (int r = 0; r < 16; ++r) p0[r] = __builtin_amdgcn_exp2f(p0[r]);
}
DEV void finishSM(f32x16& p0, f32x16& p1, float& l_reg, bf16x8& pa0, bf16x8& pa1, bf16x8& pa2, bf16x8& pa3) {
#pragma unroll
  for (int r = 0; r < 16; ++r) p1[r] = __builtin_amdgcn_exp2f(p1[r]);
  float ps = 0;
#pragma unroll
  for (int r = 0; r < 16; ++r) ps += p0[r];
#pragma unroll
  for (int r = 0; r < 16; ++r) ps += p1[r];
  { auto rr = __builtin_amdgcn_permlane32_swap(__float_as_uint(ps), __float_as_uint(ps), false, false);
    ps = __uint_as_float(rr[0]) + __uint_as_float(rr[1]); }
  l_reg += ps;
#define PK4(P, BASE, OUT) do { unsigned a0 = cvtpk(P[BASE + 0], P[BASE + 1]), a1 = cvtpk(P[BASE + 2], P[BASE + 3]);   \
    unsigned b0 = cvtpk(P[BASE + 4], P[BASE + 5]), b1 = cvtpk(P[BASE + 6], P[BASE + 7]);                              \
    auto r0 = __builtin_amdgcn_permlane32_swap(a0, b0, false, false); auto r1 = __builtin_amdgcn_permlane32_swap(a1, b1, false, false); \
    u32x4 w = {r0[0], r1[0], r0[1], r1[1]}; OUT = *reinterpret_cast<bf16x8*>(&w); } while (0)
  PK4(p0, 0, pa0); PK4(p0, 8, pa1); PK4(p1, 0, pa2); PK4(p1, 8, pa3);
#undef PK4
}
template <int DQK> DEV int koff(int row, int slot) { return row * AC<DQK>::KPITCH + slot * 16; }
constexpr int QPITCH = 272;
template <int DQK>
DEV void qkt(f32x16& p0, f32x16& p1, const char* Ks, const bf16x8* qr, const char* Ql, int r32, int hi) {
  p0 = f32x16{}; p1 = f32x16{};
  constexpr int KP = AC<DQK>::KPITCH;
  if constexpr (DQK == 192) asm volatile("" : "+v"(r32));
  const char* kb = Ks + r32 * KP + hi * 16;
  const char* qb = Ql + r32 * QPITCH + hi * 16;
#pragma unroll
  for (int d0 = 0; d0 < DQK / 16; ++d0) {
    bf16x8 b0 = *reinterpret_cast<const bf16x8*>(kb + d0 * 32);
    bf16x8 b1 = *reinterpret_cast<const bf16x8*>(kb + d0 * 32 + 32 * KP);
    bf16x8 q;
    if (DQK == 128 || d0 < 4) q = qr[d0];
    else q = *reinterpret_cast<const bf16x8*>(qb + (d0 - 4) * 32);
    p0 = __builtin_amdgcn_mfma_f32_32x32x16_bf16(b0, q, p0, 0, 0, 0);
    p1 = __builtin_amdgcn_mfma_f32_32x32x16_bf16(b1, q, p1, 0, 0, 0);
  }
}
DEV int v_st(int k, int c) { const int kk = (k & ~0xC) | ((k & 4) << 1) | ((k & 8) >> 1); return ((kk >> 3) * 4 + (c >> 5)) * 512 + ((kk & 7) * 32 + (c & 31)) * 2; }
DEV int v_rd_base(int lane) { return ((lane & 3) << 3) | (((lane >> 2) & 3) << 6) | (((lane >> 4) & 1) << 5) | (((lane >> 5) & 1) << 8); }
constexpr int v_rd_off(int d0, int ks, int half) { return d0 * 512 + ks * 4096 + half * 2048; }
template <int OFF> DEV s16x4 tr_read(int vb) {
  s16x4 r; asm volatile("ds_read_b64_tr_b16 %0, %1 offset:%2" : "=&v"(r) : "v"(vb), "i"(OFF) : "memory"); return r;
}
template <int D0> DEV void pv_one(f32x16& od, int vb, bf16x8 pa0, bf16x8 pa1, bf16x8 pa2, bf16x8 pa3) {
  const s16x4 l0 = tr_read<v_rd_off(D0, 0, 0)>(vb), h0 = tr_read<v_rd_off(D0, 0, 1)>(vb), l1 = tr_read<v_rd_off(D0, 1, 0)>(vb), h1 = tr_read<v_rd_off(D0, 1, 1)>(vb);
  const s16x4 l2 = tr_read<v_rd_off(D0, 2, 0)>(vb), h2 = tr_read<v_rd_off(D0, 2, 1)>(vb), l3 = tr_read<v_rd_off(D0, 3, 0)>(vb), h3 = tr_read<v_rd_off(D0, 3, 1)>(vb);
  asm volatile("s_waitcnt lgkmcnt(0)" ::: "memory"); SBAR();
#define PK(L, H) (bf16x8){L[0], L[1], L[2], L[3], H[0], H[1], H[2], H[3]}
  od = __builtin_amdgcn_mfma_f32_32x32x16_bf16(pa0, PK(l0, h0), od, 0, 0, 0);
  od = __builtin_amdgcn_mfma_f32_32x32x16_bf16(pa1, PK(l1, h1), od, 0, 0, 0);
  od = __builtin_amdgcn_mfma_f32_32x32x16_bf16(pa2, PK(l2, h2), od, 0, 0, 0);
  od = __builtin_amdgcn_mfma_f32_32x32x16_bf16(pa3, PK(l3, h3), od, 0, 0, 0);
#undef PK
}
DEV void pv_d0(f32x16* o, int vb, bf16x8 pa0, bf16x8 pa1, bf16x8 pa2, bf16x8 pa3) {
  pv_one<0>(o[0], vb, pa0, pa1, pa2, pa3); pv_one<1>(o[1], vb, pa0, pa1, pa2, pa3); pv_one<2>(o[2], vb, pa0, pa1, pa2, pa3); pv_one<3>(o[3], vb, pa0, pa1, pa2, pa3);
}

template <int DQK, int LDQ, int LDK, int LDV, int SD>
DEV void attn_body(const bf16* __restrict__ Qb, const bf16* __restrict__ Kh, const bf16* __restrict__ Vh,
                   const bf16* __restrict__ Km, const bf16* __restrict__ Vm, bf16* Ob, const bf16* __restrict__ Gb, int NT, char* lds, int wv) {
  constexpr int SHM_V = KVBLK * 128 * 2, SHM_K = AC<DQK>::SHM_K, CPR = DQK / 8, NCH = 64 * CPR / NTHR, ND0 = DQK / 16;
  int tid = wv * 64 + lane_id(); asm volatile("" : "+v"(tid));
  const int wid = __builtin_amdgcn_readfirstlane(tid >> 6), lane = tid & 63, r32 = lane & 31, hi = lane >> 5;
  char* V_lds = lds; char* K_lds = lds + 2 * SHM_V;
  float* wsf = (float*)(lds + 2 * SHM_V + 2 * SHM_K) + wid * 64; float* li_l = wsf;
  constexpr int NQR = DQK == 128 ? 8 : 4;
  float l_reg = 0; f32x16 o[4] = {}; bf16x8 qr[NQR];
  const bf16* Qw = Qb + (long)(wid * 32 + r32) * LDQ + hi * 8;
#pragma unroll
  for (int d0 = 0; d0 < NQR; ++d0) qr[d0] = *reinterpret_cast<const bf16x8*>(Qw + d0 * 16);
  char* Ql = lds + 86016 + wid * (32 * QPITCH);
  if constexpr (ND0 > NQR) {
#pragma unroll
    for (int d0 = NQR; d0 < ND0; ++d0)
      *reinterpret_cast<bf16x8*>(Ql + r32 * QPITCH + ((d0 - 4) * 2 + hi) * 16) = *reinterpret_cast<const bf16x8*>(Qw + d0 * 16);
  }
  const int sr = tid >> 4, sc = (tid & 15) * 8, vst0 = v_st(sr, sc);
  const unsigned vgo = (unsigned)(sr * LDV + sc) * 2u;
  const unsigned kgo0 = (unsigned)((tid >> 3) * LDK + (tid & 7) * 8) * 2u; const int kst0 = koff<DQK>(tid >> 3, tid & 7);
  const int vb0 = (int)(uintptr_t)V_lds + v_rd_base(lane);
  struct { u32x4 vs0, vs1, ks[NCH]; } sr_[SD];
  const __amdgpu_buffer_rsrc_t rk_ = __builtin_amdgcn_make_buffer_rsrc((void*)Kh, 0, 0x7fffffff, 0x00020000);
  const __amdgpu_buffer_rsrc_t rv_ = __builtin_amdgcn_make_buffer_rsrc((void*)Vh, 0, 0x7fffffff, 0x00020000);
#define KST(c) (kst0 + (c) * 128)
#define SLOAD0(i) do { const char* kp_ = (const char*)Km; const char* vp_ = (const char*)Vm; \
    sr_[i].vs0 = *reinterpret_cast<const u32x4*>(vp_ + vgo); sr_[i].vs1 = *reinterpret_cast<const u32x4*>(vp_ + 32 * LDV * 2 + vgo); \
    _Pragma("unroll") for (int c = 0; c < NCH; ++c) sr_[i].ks[c] = *reinterpret_cast<const u32x4*>(kp_ + c * 128 + kgo0); } while (0)
#define SLOAD(i, t) do { const int ko_ = ((t) - 1) * (KVBLK * LDK * 2), vo_ = ((t) - 1) * (KVBLK * LDV * 2);     \
    sr_[i].vs0 = __builtin_amdgcn_raw_buffer_load_b128(rv_, (int)vgo, vo_, 0); sr_[i].vs1 = __builtin_amdgcn_raw_buffer_load_b128(rv_, (int)vgo, vo_ + 32 * LDV * 2, 0); \
    _Pragma("unroll") for (int c = 0; c < NCH; ++c) sr_[i].ks[c] = __builtin_amdgcn_raw_buffer_load_b128(rk_, (int)kgo0 + c * 128, ko_, 0); } while (0)
#define SWRITE(b, i) do { *reinterpret_cast<u32x4*>(V_lds + (b) * SHM_V + vst0) = sr_[i].vs0; *reinterpret_cast<u32x4*>(V_lds + (b) * SHM_V + 8192 + vst0) = sr_[i].vs1; \
    _Pragma("unroll") for (int c = 0; c < NCH; ++c) *reinterpret_cast<u32x4*>(K_lds + (b) * SHM_K + KST(c)) = sr_[i].ks[c]; } while (0)
#define SWAIT() do { if constexpr (SD == 2) asm volatile("s_waitcnt vmcnt(%0)" :: "n"(2 + NCH) : "memory"); else asm volatile("s_waitcnt vmcnt(0)" ::: "memory"); } while (0)
  f32x16 pA0, pA1, pB0, pB1; bf16x8 pa0, pa1, pa2, pa3;
  constexpr int SE = 0, SO = SD - 1;
  SLOAD0(SE); asm volatile("s_waitcnt vmcnt(0)" ::: "memory"); SWRITE(0, SE); __syncthreads();
  qkt<DQK>(pA0, pA1, K_lds, qr, Ql, r32, hi);
#pragma unroll
  for (int r = 8; r < 16; ++r) pA0[r] = -1e30f;
#pragma unroll
  for (int r = 0; r < 16; ++r) pA1[r] = -1e30f;
  partialSM(pA0);
  SLOAD(SO, 1); if constexpr (SD == 2) { SLOAD(SE, 2); }
  SWAIT(); SWRITE(1, SO); __syncthreads();
  for (int j = 1; j + 1 < NT; j += 2) {
    SBAR(); qkt<DQK>(pB0, pB1, K_lds + SHM_K, qr, Ql, r32, hi);
    finishSM(pA0, pA1, l_reg, pa0, pa1, pa2, pa3); SBAR();
    if (SD == 1 || j + 2 < NT) SLOAD(SO, j + SD); SBAR();
    pv_d0(o, vb0, pa0, pa1, pa2, pa3); partialSM(pB0);
    __syncthreads(); SWAIT(); SWRITE(0, SE); SBAR();
    __syncthreads();
    SBAR(); qkt<DQK>(pA0, pA1, K_lds, qr, Ql, r32, hi);
    finishSM(pB0, pB1, l_reg, pa0, pa1, pa2, pa3); SBAR();
    if (j + 1 + SD < NT) SLOAD(SE, j + 1 + SD); SBAR();
    pv_d0(o, vb0 + SHM_V, pa0, pa1, pa2, pa3); partialSM(pA0);
    __syncthreads(); SWAIT(); if (j + 2 < NT) SWRITE(1, SO); SBAR();
    __syncthreads();
  }
  finishSM(pA0, pA1, l_reg, pa0, pa1, pa2, pa3); SBAR();
  pv_d0(o, vb0, pa0, pa1, pa2, pa3);
  {
    const int le = lane_id(), r32e = le & 31, hie = le >> 5;
    if (hie == 0) li_l[r32e] = l_reg; asm volatile("s_waitcnt lgkmcnt(0)" ::: "memory");
    float rli[16];
#pragma unroll
    for (int r = 0; r < 16; ++r) rli[r] = __builtin_amdgcn_rcpf(li_l[crow(r, hie)]);
    const unsigned eoff = (unsigned)((wid * 32 + 4 * hie) * 1024 + r32e) * 2u;
#pragma unroll
    for (int r = 0; r < 16; ++r) {
#pragma unroll
      for (int d0 = 0; d0 < 4; ++d0) {
        const long cst = (long)(((r & 3) + 8 * (r >> 2)) * 1024) * 2 + d0 * 64;
        const float g = bf2f(*reinterpret_cast<const short*>(((const char*)Gb + cst) + eoff));
        const unsigned w = cvtpk(o[d0][r] * rli[r] * g, 0.f);
        *reinterpret_cast<unsigned short*>(((char*)Ob + cst) + eoff) = (unsigned short)(w & 0xffffu); } }
  }
#undef SLOAD
#undef SLOAD0
#undef KST
#undef SWRITE
#undef SWAIT
}
DEV void phase3(const Params& p, int pass, char* lds, int wv) {
  char* ws = uni(p.ws);
  const int nkeys = pass < 2 ? 2048 : 16384, NT = nkeys / 64 + 1;
  const bool xmap = (gridDim.x == 256);
  const int vb_ = vblock(), vx = vb_ >> 5, vs = vb_ & 31;
  for (int it0 = blockIdx.x; it0 < 1024; it0 += gridDim.x) {
    __syncthreads();
    const int rnd = it0 >> 8;
    const int it = xmap ? (rnd >> 1) * 512 + (((rnd & 1) * 4 + (vs >> 3)) << 6) + vx * 8 + (vs & 7) : it0;
    const int i = it & 511, head = i >> 6, qb = i & 63;
    const long t0 = (long)qb * 256, kv0 = pass < 2 ? (long)(qb >> 3) * 2048 : 0;
    if (it < 512) {
      const int kvh = head >> 2;
      bf16* Q = (bf16*)(ws + OFF_QA) + t0 * 1024 + head * 128;
      attn_body<128, 1024, 256, 256, 2>(Q, (const bf16*)(ws + OFF_KA) + kv0 * 256 + kvh * 128, (const bf16*)(ws + OFF_VA) + kv0 * 256 + kvh * 128,
                                        (const bf16*)(ws + OFF_KAM) + kvh * 128, (const bf16*)(ws + OFF_VAM) + kvh * 128,
                                        Q, (const bf16*)(ws + OFF_GA) + t0 * 1024 + head * 128, NT, lds, wv);
    } else {
      bf16* O = (bf16*)(ws + OFF_HB) + ((long)pass * TP + t0) * 1024 + head * 128;
      attn_body<192, 1536, 1536, 1024, 1>((const bf16*)(ws + OFF_QB) + t0 * 1536 + head * 192, (const bf16*)(ws + OFF_KB) + kv0 * 1536 + head * 192,
                                          (const bf16*)(ws + OFF_VB) + kv0 * 1024 + head * 128, (const bf16*)(ws + OFF_KBM) + head * 192,
                                          (const bf16*)(ws + OFF_VBM) + head * 128, O, (const bf16*)(ws + OFF_GB) + t0 * 1024 + head * 128, NT, lds, wv);
    }
  }
}

DEV void p4_tile(const Params& p, int pass, int mt, int nt, char* lds, int wv) {
  char* ws = uni(p.ws);
  int tid = wv * 64 + lane_id(); asm volatile("" : "+v"(tid));
  const int lane = tid & 63, wid = __builtin_amdgcn_readfirstlane(tid >> 6), r32 = lane & 31, hi = lane >> 5;
  const int wm = wid >> 1, wn = wid & 1;
  f32x16 acc[2][4]; float dummy[2] = {0.f, 0.f};
#pragma unroll
  for (int a = 0; a < 2; ++a)
#pragma unroll
    for (int b = 0; b < 4; ++b) acc[a][b] = f32x16{};
  gemm_main<2, 4, 4, 2, false>(acc, dummy, (const bf16*)(ws + OFF_QA) + (long)mt * 256 * 1024, 1024,
                               (const bf16*)(ws + OFF_WPA) + (long)nt * 256 * 1024, 1024, 16, lds, tid);
#pragma unroll
  for (int mb = 0; mb < 2; ++mb) {
    const long tl = (long)mt * 256 + (wm * 2 + mb) * 32 + r32;
    const bf16* sa = (const bf16*)(ws + OFF_SA) + tl * 1024 + nt * 256 + wn * 128;
    const bf16* sb = (const bf16*)(ws + OFF_SB) + tl * 1024 + nt * 256 + wn * 128;
#pragma unroll
    for (int nb = 0; nb < 4; ++nb)
#pragma unroll
      for (int q = 0; q < 4; ++q) {
        float a0, a1, a2, a3, b0, b1, b2, b3; const int col = nb * 32 + 8 * q + 4 * hi;
        ld4(sa + col, a0, a1, a2, a3); ld4(sb + col, b0, b1, b2, b3);
        acc[mb][nb][4 * q] *= a0 / b0; acc[mb][nb][4 * q + 1] *= a1 / b1; acc[mb][nb][4 * q + 2] *= a2 / b2; acc[mb][nb][4 * q + 3] *= a3 / b3;
      }
  }
  gemm_main<2, 4, 4, 2, false>(acc, dummy, (const bf16*)(ws + OFF_HB) + ((long)pass * TP + mt * 256) * 1024, 1024,
                               (const bf16*)(ws + OFF_WPB) + (long)nt * 256 * 1024, 1024, 16, lds, tid);
#pragma unroll
  for (int mb = 0; mb < 2; ++mb) {
    const long tl = (long)mt * 256 + (wm * 2 + mb) * 32 + r32;
    const bf16* sb = (const bf16*)(ws + OFF_SB) + tl * 1024 + nt * 256 + wn * 128;
    bf16* md = (bf16*)(ws + OFF_MM) + tl * 1024 + nt * 256 + wn * 128;
#pragma unroll
    for (int nb = 0; nb < 4; ++nb)
#pragma unroll
      for (int q = 0; q < 4; ++q) {
        float b0, b1, b2, b3; const int col = nb * 32 + 8 * q + 4 * hi;
        ld4(sb + col, b0, b1, b2, b3);
        st4(md + col, acc[mb][nb][4 * q] * b0, acc[mb][nb][4 * q + 1] * b1, acc[mb][nb][4 * q + 2] * b2, acc[mb][nb][4 * q + 3] * b3);
      }
  }
}
DEV void p5_tile(const Params& p, int pass, int mt, int nt, char* lds, int wv) {
  char* ws = uni(p.ws);
  int tid = wv * 64 + lane_id(); asm volatile("" : "+v"(tid));
  const int lane = tid & 63, wid = __builtin_amdgcn_readfirstlane(tid >> 6), r32 = lane & 31, hi = lane >> 5;
  const int wm = wid >> 1, wn = wid & 1;
  f32x16 acc[2][4]; float dummy[2] = {0.f, 0.f};
#pragma unroll
  for (int a = 0; a < 2; ++a)
#pragma unroll
    for (int b = 0; b < 4; ++b) acc[a][b] = f32x16{};
  gemm_main<2, 4, 4, 2, false>(acc, dummy, (const bf16*)(ws + OFF_MM) + (long)mt * 256 * 1024, 1024,
                               (const bf16*)(ws + OFF_WO) + (long)nt * 256 * 1024, 1024, 16, lds, tid);
  constexpr int P5PITCH = 528;
  char* strip = lds + wid * (32 * P5PITCH);
#pragma unroll
  for (int mb = 0; mb < 2; ++mb) {
    const long g0 = (long)pass * TP + (long)mt * 256 + (wm * 2 + mb) * 32;
    const float* xs0 = (pass < 2 ? uni(p.x_prompt) + g0 * 1024 : uni(p.x_sample) + (g0 - 32768) * 1024) + nt * 256 + wn * 128;
    float* od0 = uni(p.out) + g0 * 1024 + nt * 256 + wn * 128;
#pragma unroll
    for (int nb = 0; nb < 4; ++nb)
#pragma unroll
      for (int q = 0; q < 4; ++q) {
        const f32x4 v = {acc[mb][nb][4 * q], acc[mb][nb][4 * q + 1], acc[mb][nb][4 * q + 2], acc[mb][nb][4 * q + 3]};
        *reinterpret_cast<LAS f32x4*>((LAS char*)(strip + r32 * P5PITCH + (nb * 32 + 8 * q + 4 * hi) * 4)) = v;
      }
#pragma unroll
    for (int i2 = 0; i2 < 16; ++i2) {
      const int row = i2 * 2 + (lane >> 5), ch = lane & 31;
      const f32x4 a = *reinterpret_cast<const LAS f32x4*>((const LAS char*)(strip + row * P5PITCH + ch * 16));
      f32x4 x = *reinterpret_cast<const f32x4*>(xs0 + (long)row * 1024 + ch * 4);
      x[0] += a[0]; x[1] += a[1]; x[2] += a[2]; x[3] += a[3];
      *reinterpret_cast<f32x4*>(od0 + (long)row * 1024 + ch * 4) = x;
    }
  }
}

#define XB_TMO      128
#define XB_XCNT(j)  (256  + 64 * (j))
#define XB_XSUB(j)  (1280 + 64 * (j))
#define XB_XGEN(j)  (2304 + 64 * (j))
#define XB_TOP      3328
#define XB_TOPGEN   3392
#define XB_SPIN_CAP (1u << 18)
DEV unsigned xb_ld(unsigned* p)              { return __hip_atomic_load(p, __ATOMIC_RELAXED, __HIP_MEMORY_SCOPE_AGENT); }
DEV unsigned xb_add(unsigned* p, unsigned v) { return __hip_atomic_fetch_add(p, v, __ATOMIC_RELAXED, __HIP_MEMORY_SCOPE_AGENT); }
DEV unsigned xb_xcc_id() { return (unsigned)__builtin_amdgcn_s_getreg((3 << 11) | 20) & 0xFu; }
#define XB_SPIN(cond, bar) do { unsigned _sp = 0; while (cond) { __builtin_amdgcn_s_sleep(1); \
    if ((++_sp & 255u) == 0u) { if (xb_ld(&(bar)[XB_TMO])) break; if (_sp > XB_SPIN_CAP) { atomicAdd(&(bar)[XB_TMO], 1u); break; } } } } while (0)
DEV void xcd_barrier_complete(unsigned* bar, unsigned x, unsigned& nloc, unsigned& nx) {
  const unsigned G = gridDim.x;
  unsigned sum, cnt, mine, sp = 0u;
  for (;;) {
    sum = 0u; cnt = 0u; mine = 0u;
#pragma unroll
    for (unsigned j = 0; j < 16; ++j) { const unsigned c = xb_ld(&bar[XB_XCNT(j)]); sum += c; cnt += (c > 0u) ? 1u : 0u; mine = (j == x) ? c : mine; }
    if (sum == G) break;
    __builtin_amdgcn_s_sleep(1);
    if ((++sp & 255u) == 0u) { if (xb_ld(&bar[XB_TMO])) break; if (sp > XB_SPIN_CAP) { atomicAdd(&bar[XB_TMO], 1u); break; } }
  }
  nloc = mine > 0u ? mine : 1u; nx = cnt > 0u ? cnt : 1u;
}
DEV void xcd_barrier(unsigned* bar, unsigned x, volatile LAS unsigned* st, int wv) {
  asm volatile("s_waitcnt vmcnt(0)" ::: "memory");
  __syncthreads();
  if (wv == 0 && lane_id() == 0) {
    __builtin_amdgcn_s_waitcnt(0);
    unsigned nloc = st[0], nx = st[1];
    if (nloc == 0u) { xcd_barrier_complete(bar, x, nloc, nx); st[0] = nloc; st[1] = nx; }
    const unsigned old = xb_add(&bar[XB_XSUB(x)], 1u);
    const unsigned gen = old / nloc;
    if (old + 1u == (gen + 1u) * nloc) {
      __builtin_amdgcn_fence(__ATOMIC_RELEASE, "agent");
      asm volatile("s_waitcnt vmcnt(0)" ::: "memory");
      const unsigned og = xb_add(&bar[XB_TOP], 1u);
      const unsigned tg = og / nx;
      if (og + 1u == (tg + 1u) * nx) xb_add(&bar[XB_TOPGEN], 1u);
      else XB_SPIN(xb_ld(&bar[XB_TOPGEN]) == tg, bar);
      __builtin_amdgcn_fence(__ATOMIC_ACQUIRE, "agent");
      xb_add(&bar[XB_XGEN(x)], 1u);
      asm volatile("s_waitcnt vmcnt(0)" ::: "memory");
    } else {
      XB_SPIN(xb_ld(&bar[XB_XGEN(x)]) == gen, bar);
      __builtin_amdgcn_fence(__ATOMIC_ACQUIRE, "agent");
      asm volatile("s_waitcnt vmcnt(0)" ::: "memory");
    }
  }
  __syncthreads();
}

__global__ void __launch_bounds__(NTHR) mega_fwd(Params p) {
  extern __shared__ __attribute__((aligned(16))) char lds[];
  cg::grid_group grid = cg::this_grid();
  const int wv = __builtin_amdgcn_readfirstlane((int)threadIdx.x >> 6);
#ifndef PHM
#define PHM 63
#endif
  volatile LAS unsigned* xst = (volatile LAS unsigned*)(lds + LDS_XB_OFF);
  const unsigned xcc = xb_xcc_id();
  if (wv == 0 && lane_id() == 0) { xst[0] = 0u; xst[1] = 0u; xst[2] = 0u; xst[3] = 0u; (void)xb_add(&((unsigned*)(uni(p.ws) + OFF_BAR))[XB_XCNT(xcc)], 1u); }
  __syncthreads();
#define GSYNC() xcd_barrier((unsigned*)(uni(p.ws) + OFF_BAR), xcc, xst, wv)
  if (PHM & 1) phase0(p, lds, wv);
  grid.sync();
  for (int pass = 0; pass < 3; ++pass) {
    if (PHM & 2) phase1(p, pass, lds, wv);
    GSYNC();
    if (PHM & 4) phase2(p, pass, lds, wv);
    GSYNC();
    if (PHM & 8) phase3(p, pass, lds, wv);
    GSYNC();
    if (PHM & 16) for (int t = vblock(); t < 256; t += gridDim.x) p4_tile(p, pass, (t >> 5) * 8 + (t & 7), (t >> 3) & 3, lds, wv);
    GSYNC();
    if (PHM & 32) for (int t = vblock(); t < 256; t += gridDim.x) p5_tile(p, pass, (t >> 5) * 8 + (t & 7), (t >> 3) & 3, lds, wv);
  }
#undef GSYNC
}

extern "C" void kernel_launch(void* const* d_in, const int* in_sizes, int n_in, void* d_out, int out_size, void* d_ws, size_t ws_size, hipStream_t stream) {
  static int grid_blocks = 0;
  if (grid_blocks == 0) {
    if (n_in != 17 || ws_size < WS_END || out_size != NREAL * DM) {
      fprintf(stderr, "kernel_launch: unexpected shapes: n_in %d out %d ws %zu (need %zu)\n", n_in, out_size, ws_size, (size_t)WS_END); grid_blocks = -1; return; }
    int dev = 0, cus = 0, per_cu = 0;
    (void)hipGetDevice(&dev);
    (void)hipDeviceGetAttribute(&cus, hipDeviceAttributeMultiprocessorCount, dev);
    if (hipFuncSetAttribute((const void*)mega_fwd, hipFuncAttributeMaxDynamicSharedMemorySize, LDS_BYTES) != hipSuccess) {
      fprintf(stderr, "kernel_launch: hipFuncSetAttribute failed\n"); grid_blocks = -1; return; }
    if (hipOccupancyMaxActiveBlocksPerMultiprocessor(&per_cu, (const void*)mega_fwd, NTHR, LDS_BYTES) != hipSuccess || per_cu < 1) {
      fprintf(stderr, "kernel_launch: occupancy query failed (%d)\n", per_cu); per_cu = 1; (void)hipGetLastError(); }
    grid_blocks = cus * per_cu;
  }
  if (grid_blocks < 0) return;
  Params p{};
  p.x_prompt = (const float*)d_in[0]; p.x_sample = (const float*)d_in[1]; p.meta = (const float*)d_in[2]; p.norm_gain = (const float*)d_in[3];
  p.w_in = (const float*)d_in[4]; p.b_merge = (const float*)d_in[5]; p.qna = (const float*)d_in[6]; p.kna = (const float*)d_in[7];
  p.cqn = (const float*)d_in[8]; p.ckvn = (const float*)d_in[9]; p.w_uq = (const float*)d_in[10]; p.w_ukv = (const float*)d_in[11];
  p.qnb = (const float*)d_in[12]; p.knb = (const float*)d_in[13]; p.wpa = (const float*)d_in[14]; p.wpb = (const float*)d_in[15]; p.wo = (const float*)d_in[16];
  p.out = (float*)d_out; p.ws = (char*)d_ws;
  if (hipMemsetAsync((char*)d_ws + OFF_BAR, 0, BAR_BYTES, stream) != hipSuccess) { fprintf(stderr, "kernel_launch: barrier memset failed\n"); return; }
  void* args[] = {&p};
  hipError_t e = hipLaunchCooperativeKernel((const void*)mega_fwd, dim3(grid_blocks), dim3(NTHR), args, LDS_BYTES, stream);
  if (e != hipSuccess) fprintf(stderr, "cooperative launch failed: %s (grid %d)\n", hipGetErrorString(e), grid_blocks);
}
```

```cpp
#include <hip/hip_runtime.h>
#include <hip/hip_bf16.h>
#include <hip/hip_cooperative_groups.h>
#include <cstdio>
#include <cstdint>
namespace cg = cooperative_groups;

using bf16 = __hip_bfloat16;
using bf16x8 = __attribute__((ext_vector_type(8))) short;
using s16x4  = __attribute__((ext_vector_type(4))) short;
using f32x16 = __attribute__((ext_vector_type(16))) float;
using f32x4  = __attribute__((ext_vector_type(4))) float;
using u32x4  = __attribute__((ext_vector_type(4))) unsigned;
using u32x2  = __attribute__((ext_vector_type(2))) unsigned;
#define DEV __device__ __forceinline__
#define SBAR() __builtin_amdgcn_sched_barrier(0)
#define LAS __attribute__((address_space(3)))

constexpr int DM = 1024;
constexpr int NREAL = 49152;
constexpr int TP = 16384;
constexpr int NHB = NREAL + 256;
constexpr int NCOL = 6400;
constexpr float EPS = 1e-6f;
constexpr float QSCALE_A = 0.088388347648318440f * 1.4426950408889634f;
constexpr float QSCALE_B = 0.072168783648703220f * 1.4426950408889634f;
constexpr int NTHR = 512;
constexpr int LDS_XB_OFF = 155648;
constexpr int LDS_BYTES = LDS_XB_OFF + 16;

constexpr size_t al256(size_t x) { return (x + 255) & ~(size_t)255; }
constexpr size_t OFF_WIN  = 0;
constexpr size_t OFF_WUQ  = OFF_WIN  + al256((size_t)NCOL * 1024 * 2);
constexpr size_t OFF_WUKV = OFF_WUQ  + al256((size_t)1536 * 384 * 2);
constexpr size_t OFF_WPA  = OFF_WUKV + al256((size_t)2048 * 256 * 2);
constexpr size_t OFF_WPB  = OFF_WPA  + al256((size_t)1024 * 1024 * 2);
constexpr size_t OFF_WO   = OFF_WPB  + al256((size_t)1024 * 1024 * 2);
constexpr size_t OFF_RAR  = OFF_WO   + al256((size_t)1024 * 1024 * 2);
constexpr size_t OFF_RAC  = OFF_RAR  + al256((size_t)257 * 32 * 8);
constexpr size_t OFF_RBR  = OFF_RAC  + al256((size_t)65 * 32 * 8);
constexpr size_t OFF_RBC  = OFF_RBR  + al256((size_t)257 * 16 * 8);
constexpr size_t OFF_RSTD = OFF_RBC  + al256((size_t)65 * 16 * 8);
constexpr size_t OFF_SMALL = OFF_RSTD + al256((size_t)NHB * 4);
constexpr size_t OFF_KAM  = OFF_SMALL + al256((size_t)2688 * 4);
constexpr size_t OFF_VAM  = OFF_KAM  + al256((size_t)64 * 256 * 2);
constexpr size_t OFF_KBM  = OFF_VAM  + al256((size_t)64 * 256 * 2);
constexpr size_t OFF_VBM  = OFF_KBM  + al256((size_t)64 * 1536 * 2);
constexpr size_t OFF_HB   = OFF_VBM  + al256((size_t)64 * 1024 * 2);
constexpr size_t OFF_QA   = OFF_HB   + al256((size_t)NHB * 1024 * 2);
constexpr size_t OFF_GA   = OFF_QA   + al256((size_t)TP * 1024 * 2);
constexpr size_t OFF_GB   = OFF_GA   + al256((size_t)TP * 1024 * 2);
constexpr size_t OFF_SA   = OFF_GB   + al256((size_t)TP * 1024 * 2);
constexpr size_t OFF_SB   = OFF_SA   + al256((size_t)TP * 1024 * 2);
constexpr size_t OFF_MM   = OFF_SB   + al256((size_t)TP * 1024 * 2);
constexpr size_t OFF_VB   = OFF_MM   + al256((size_t)TP * 1024 * 2);
constexpr size_t OFF_QB   = OFF_VB   + al256((size_t)TP * 1024 * 2);
constexpr size_t OFF_KB   = OFF_QB   + al256((size_t)TP * 1536 * 2);
constexpr size_t OFF_KA   = OFF_KB   + al256((size_t)TP * 1536 * 2);
constexpr size_t OFF_VA   = OFF_KA   + al256((size_t)TP * 256 * 2);
constexpr size_t OFF_CQ   = OFF_VA   + al256((size_t)TP * 256 * 2);
constexpr size_t OFF_CKV  = OFF_CQ   + al256((size_t)TP * 384 * 2);
constexpr size_t OFF_KR   = OFF_CKV  + al256((size_t)(TP + 256) * 256 * 2);
constexpr size_t OFF_BAR  = OFF_KR   + al256((size_t)(TP + 256) * 64 * 2);
constexpr size_t BAR_BYTES = 3456 * 4;
constexpr size_t WS_END   = OFF_BAR  + al256(BAR_BYTES);

struct Params {
  const float *x_prompt, *x_sample, *meta, *norm_gain, *w_in, *b_merge, *qna, *kna, *cqn, *ckvn, *w_uq, *w_ukv, *qnb, *knb, *wpa, *wpb, *wo;
  float* out; char* ws;
};

DEV int crow(int r, int hi) { return (r & 3) + 8 * (r >> 2) + 4 * hi; }
DEV unsigned cvtpk(float lo, float hi) { unsigned r; asm("v_cvt_pk_bf16_f32 %0, %1, %2" : "=v"(r) : "v"(lo), "v"(hi)); return r; }
DEV float bf2f(short s) { return __uint_as_float(((unsigned)(unsigned short)s) << 16); }
DEV void st4(bf16* p, float a, float b, float c, float d) { u32x2 w = {cvtpk(a, b), cvtpk(c, d)}; *reinterpret_cast<u32x2*>(p) = w; }
DEV void ld4(const bf16* p, float& a, float& b, float& c, float& d) {
  u32x2 w = *reinterpret_cast<const u32x2*>(p);
  a = __uint_as_float(w[0] << 16); b = __uint_as_float(w[0] & 0xffff0000u); c = __uint_as_float(w[1] << 16); d = __uint_as_float(w[1] & 0xffff0000u);
}
template <typename T> DEV T* uni(T* q) {
  const uint64_t v = (uint64_t)q; unsigned lo = (unsigned)v, hi = (unsigned)(v >> 32);
  asm volatile("" : "+s"(lo), "+s"(hi));
  return (T*)((__attribute__((address_space(1))) T*)(((uint64_t)hi << 32) | lo)); }
DEV int lane_id() { int l; asm volatile("v_mbcnt_lo_u32_b32 %0, -1, 0\n\tv_mbcnt_hi_u32_b32 %0, -1, %0" : "=v"(l)); return l; }
DEV float halfsum(float v) { auto rr = __builtin_amdgcn_permlane32_swap(__float_as_uint(v), __float_as_uint(v), false, false); return __uint_as_float(rr[0]) + __uint_as_float(rr[1]); }
DEV float silu_f(float x) { return x / (1.f + __expf(-x)); }
DEV float sigm_f(float x) { return 1.f / (1.f + __expf(-x)); }

template <int MB, int NB, int WM, int WN, bool SSQ>
DEV void gemm_main(f32x16 (&acc)[MB][NB], float (&ssq)[MB], const bf16* __restrict__ A, int lda,
                   const bf16* __restrict__ W, int ldw, int KT, char* lds, int tid) {
  constexpr int BN = WN * NB * 32; constexpr int NCW = BN / 64;
  const int lane = tid & 63, wid = __builtin_amdgcn_readfirstlane(tid >> 6), r32 = lane & 31, hi = lane >> 5;
  const int wm = wid / WN, wn = wid % WN;
  const int srow = tid >> 3, sslot = tid & 7;
  const unsigned aoff = (unsigned)(srow * lda + sslot * 8) * 2u, woffg = (unsigned)(srow * ldw + sslot * 8) * 2u;
  const int woff = srow * 128 + ((sslot ^ ((srow >> 1) & 7)) << 4);
  bf16x8 sa[4], sw[NCW];
#define GLOAD(kt_) do { _Pragma("unroll") for (int i = 0; i < 4; ++i) sa[i] = *reinterpret_cast<const bf16x8*>((const char*)(A + (long)i * 64 * lda + (kt_) * 64) + aoff); \
    _Pragma("unroll") for (int i = 0; i < NCW; ++i) sw[i] = *reinterpret_cast<const bf16x8*>((const char*)(W + (long)i * 64 * ldw + (kt_) * 64) + woffg); } while (0)
#define LWRITE(b_) do { char* d_ = lds + (b_) * 65536 + woff; \
    _Pragma("unroll") for (int i = 0; i < 4; ++i) *reinterpret_cast<bf16x8*>(d_ + i * 8192) = sa[i]; \
    _Pragma("unroll") for (int i = 0; i < NCW; ++i) *reinterpret_cast<bf16x8*>(d_ + 32768 + i * 8192) = sw[i]; } while (0)
#define LOADF(AF, WF, cb_, ks_) do { const int so = (((ks_) * 2 + hi) ^ swz) << 4; \
    _Pragma("unroll") for (int mb = 0; mb < MB; ++mb) AF[mb] = *reinterpret_cast<const bf16x8*>((cb_) + abase + mb * 4096 + so); \
    _Pragma("unroll") for (int nb = 0; nb < NB; ++nb) WF[nb] = *reinterpret_cast<const bf16x8*>((cb_) + 32768 + wbase + nb * 4096 + so); } while (0)
#define MMA(AF, WF) do { _Pragma("unroll") for (int mb = 0; mb < MB; ++mb) _Pragma("unroll") for (int nb = 0; nb < NB; ++nb) \
      acc[mb][nb] = __builtin_amdgcn_mfma_f32_32x32x16_bf16(WF[nb], AF[mb], acc[mb][nb], 0, 0, 0); } while (0)
  const int swz = (r32 >> 1) & 7;
  const int abase = (wm * MB * 32 + r32) * 128, wbase = (wn * NB * 32 + r32) * 128;
  bf16x8 af0[MB], wf0[NB], af1[MB], wf1[NB];
  GLOAD(0);
  __syncthreads();
  LWRITE(0);
  if (KT > 1) GLOAD(1);
  __syncthreads();
  LOADF(af0, wf0, lds, 0);
  for (int kt = 0; kt < KT; ++kt) {
    const char* cb = lds + (kt & 1) * 65536; const char* nb_ = lds + ((kt + 1) & 1) * 65536;
    LOADF(af1, wf1, cb, 1); SBAR(); MMA(af0, wf0); SBAR();
    LOADF(af0, wf0, cb, 2); SBAR(); MMA(af1, wf1); SBAR();
    if (kt + 1 < KT) LWRITE((kt + 1) & 1);
    if (kt + 2 < KT) GLOAD(kt + 2);
    SBAR();
    LOADF(af1, wf1, cb, 3); SBAR(); MMA(af0, wf0); SBAR();
    __syncthreads();
    if (kt + 1 < KT) LOADF(af0, wf0, nb_, 0);
    SBAR(); MMA(af1, wf1); SBAR();
  }
  __syncthreads();
#undef GLOAD
#undef LWRITE
#undef LOADF
#undef MMA
}

DEV void prep_tr_tile(const float* __restrict__ src, int K, int N, bf16* __restrict__ dst, const float* __restrict__ gain,
                      int kt, int ct, int rowshift, char* lds, int wv) {
  float* T = reinterpret_cast<float*>(lds);
  int tid = wv * 64 + lane_id(); asm volatile("" : "+v"(tid));
  { const int i = tid >> 3, j0 = (tid & 7) * 8;
    const float* s = src + (long)(kt * 64 + i) * N + ct * 64 + j0;
    f32x4 a = *reinterpret_cast<const f32x4*>(s), b = *reinterpret_cast<const f32x4*>(s + 4);
    float g = gain ? gain[kt * 64 + i] : 1.f;
    float* t = T + i * 65 + j0;
    t[0] = a[0] * g; t[1] = a[1] * g; t[2] = a[2] * g; t[3] = a[3] * g; t[4] = b[0] * g; t[5] = b[1] * g; t[6] = b[2] * g; t[7] = b[3] * g; }
  __syncthreads();
  { const int jj = tid >> 3, i0 = (tid & 7) * 8;
    u32x4 w;
    w[0] = cvtpk(T[(i0 + 0) * 65 + jj], T[(i0 + 1) * 65 + jj]); w[1] = cvtpk(T[(i0 + 2) * 65 + jj], T[(i0 + 3) * 65 + jj]);
    w[2] = cvtpk(T[(i0 + 4) * 65 + jj], T[(i0 + 5) * 65 + jj]); w[3] = cvtpk(T[(i0 + 6) * 65 + jj], T[(i0 + 7) * 65 + jj]);
    *reinterpret_cast<u32x4*>(dst + (long)(ct * 64 + jj + rowshift) * K + kt * 64 + i0) = w; }
  __syncthreads();
}

DEV void phase0(const Params& p, char* lds, int wv) {
  char* ws = uni(p.ws);
  int tid = wv * 64 + lane_id(); asm volatile("" : "+v"(tid));
  const int bid = blockIdx.x, G = gridDim.x;
  constexpr int T_WIN = 16 * 99, T_WUQ = 6 * 24, T_WUKV = 4 * 32, T_P = 16 * 16;
  constexpr int T_ALL = T_WIN + T_WUQ + T_WUKV + 3 * T_P;
  for (int t = bid; t < T_ALL; t += G) {
    int u = t;
    if (u < T_WIN) { int ct = u % 99, kt = u / 99; prep_tr_tile(uni(p.w_in), 1024, 6336, (bf16*)(ws + OFF_WIN), uni(p.norm_gain), kt, ct, ct > 50 ? 64 : 0, lds, wv); continue; }
    u -= T_WIN;
    if (u < T_WUQ) { int ct = u % 24, kt = u / 24; prep_tr_tile(uni(p.w_uq), 384, 1536, (bf16*)(ws + OFF_WUQ), uni(p.cqn), kt, ct, 0, lds, wv); continue; }
    u -= T_WUQ;
    if (u < T_WUKV) { int ct = u % 32, kt = u / 32; prep_tr_tile(uni(p.w_ukv), 256, 2048, (bf16*)(ws + OFF_WUKV), uni(p.ckvn), kt, ct, 0, lds, wv); continue; }
    u -= T_WUKV;
    { int which = u / T_P, v = u % T_P, ct = v % 16, kt = v / 16;
      const float* src = which == 0 ? uni(p.wpa) : (which == 1 ? uni(p.wpb) : uni(p.wo));
      bf16* dst = (bf16*)(ws + (which == 0 ? OFF_WPA : (which == 1 ? OFF_WPB : OFF_WO)));
      prep_tr_tile(src, 1024, 1024, dst, nullptr, kt, ct, 0, lds, wv); }
  }
  const int gt = bid * NTHR + tid, GT = G * NTHR;
  for (int i = gt; i < 64 * 1024 / 8; i += GT) reinterpret_cast<u32x4*>(ws + OFF_WIN + (size_t)3264 * 1024 * 2)[i] = u32x4{0, 0, 0, 0};
  for (int i = gt; i < (int)((OFF_HB - OFF_KAM) / 16); i += GT) reinterpret_cast<u32x4*>(ws + OFF_KAM)[i] = u32x4{0, 0, 0, 0};
  { float* sm = (float*)(ws + OFF_SMALL);
    for (int i = gt; i < 2688; i += GT) {
      float v;
      if (i < 2048) v = uni(p.b_merge)[i]; else if (i < 2176) v = uni(p.qna)[i - 2048]; else if (i < 2304) v = uni(p.kna)[i - 2176];
      else if (i < 2496) v = uni(p.qnb)[i - 2304]; else v = uni(p.knb)[i - 2496];
      sm[i] = v; } }
  {
    float2* rar = (float2*)(ws + OFF_RAR); float2* rac = (float2*)(ws + OFF_RAC); float2* rbr = (float2*)(ws + OFF_RBR); float2* rbc = (float2*)(ws + OFF_RBC);
    constexpr int N1 = 257 * 32, N2 = 65 * 32, N3 = 257 * 16, N4 = 65 * 16;
    for (int i = gt; i < N1 + N2 + N3 + N4; i += GT) {
      int u = i; float2* dst; int pos, f, nf, ident;
      if (u < N1) { dst = rar + u; pos = u / 32; f = u % 32; nf = 32; ident = 256; }
      else if ((u -= N1) < N2) { dst = rac + u; pos = u / 32; f = u % 32; nf = 32; ident = 64; }
      else if ((u -= N2) < N3) { dst = rbr + u; pos = u / 16; f = u % 16; nf = 16; ident = 256; }
      else { u -= N3; dst = rbc + u; pos = u / 16; f = u % 16; nf = 16; ident = 64; }
      float c = 1.f, s = 0.f;
      if (pos != ident) {
        float invf = exp2f(-13.287712379549449f * (float)f / (float)nf);
        float ang = (float)pos * invf;
        double rv = (double)ang * 0.15915494309189535; rv -= rint(rv);
        float rf = (float)rv;
        c = __builtin_amdgcn_cosf(rf); s = __builtin_amdgcn_sinf(rf);
      }
      *dst = make_float2(c, s);
    }
  }
  {
    const int lane = tid & 63, gw = bid * 8 + (tid >> 6), GW = G * 8;
    bf16* HB = (bf16*)(ws + OFF_HB); float* RS = (float*)(ws + OFF_RSTD);
    for (int row0 = gw; row0 < NHB; row0 += 2 * GW) {
      f32x4 v[2][4]; float ss[2] = {0.f, 0.f}; bool has[2];
#pragma unroll
      for (int u = 0; u < 2; ++u) {
        const int row = row0 + u * GW;
        const float* src = nullptr;
        if (row < 32768) src = uni(p.x_prompt) + (long)row * 1024;
        else if (row < NREAL) src = uni(p.x_sample) + (long)(row - 32768) * 1024;
        else if (row < NREAL + 16) src = uni(p.meta) + (long)(row - NREAL) * 1024;
        has[u] = (src != nullptr);
#pragma unroll
        for (int j = 0; j < 4; ++j) v[u][j] = src ? *reinterpret_cast<const f32x4*>(src + j * 256 + lane * 4) : f32x4{0, 0, 0, 0};
      }
#pragma unroll
      for (int u = 0; u < 2; ++u) {
        const int row = row0 + u * GW;
#pragma unroll
        for (int j = 0; j < 4; ++j) ss[u] += v[u][j][0] * v[u][j][0] + v[u][j][1] * v[u][j][1] + v[u][j][2] * v[u][j][2] + v[u][j][3] * v[u][j][3];
#pragma unroll
        for (int o = 1; o < 64; o <<= 1) ss[u] += __uint_as_float(__builtin_amdgcn_ds_bpermute((lane ^ o) << 2, __float_as_uint(ss[u])));
        if (row < NHB) {
#pragma unroll
          for (int j = 0; j < 4; ++j) st4(HB + (long)row * 1024 + j * 256 + lane * 4, v[u][j][0], v[u][j][1], v[u][j][2], v[u][j][3]);
          if (lane == 0) RS[row] = has[u] ? rsqrtf(ss[u] * (1.f / 1024.f) + EPS) : 0.f;
        }
      }
    }
  }
}

template <int MODE, int NBLK>
DEV void store_plain(const f32x16* a, float rstd, bf16* dst, const float* bias, int hi) {
#pragma unroll
  for (int nb = 0; nb < NBLK; ++nb)
#pragma unroll
    for (int q = 0; q < 4; ++q) {
      const int col = nb * 32 + 8 * q + 4 * hi;
      float v0 = a[nb][4 * q] * rstd, v1 = a[nb][4 * q + 1] * rstd, v2 = a[nb][4 * q + 2] * rstd, v3 = a[nb][4 * q + 3] * rstd;
      if constexpr (MODE == 1) { v0 = silu_f(v0); v1 = silu_f(v1); v2 = silu_f(v2); v3 = silu_f(v3); }
      if constexpr (MODE == 2) { f32x4 b = *reinterpret_cast<const f32x4*>(bias + col);
        v0 = sigm_f(v0 + b[0]); v1 = sigm_f(v1 + b[1]); v2 = sigm_f(v2 + b[2]); v3 = sigm_f(v3 + b[3]); }
      st4(dst + col, v0, v1, v2, v3);
    }
}
DEV void rope_pair32(f32x16& y1, f32x16& y2, const float2* tab, int hi) {
#pragma unroll
  for (int q = 0; q < 4; ++q) {
    const f32x4 t0 = *reinterpret_cast<const f32x4*>(tab + 8 * q + 4 * hi), t1 = *reinterpret_cast<const f32x4*>(tab + 8 * q + 4 * hi + 2);
    const float cs[4] = {t0[0], t0[2], t1[0], t1[2]}, sn[4] = {t0[1], t0[3], t1[1], t1[3]};
#pragma unroll
    for (int j = 0; j < 4; ++j) { const int r = 4 * q + j; float a = y1[r], b = y2[r]; y1[r] = a * cs[j] - b * sn[j]; y2[r] = a * sn[j] + b * cs[j]; }
  }
}
DEV void rope_in32(f32x16& y, const float2* tab, int hi) {
#pragma unroll
  for (int q = 0; q < 2; ++q) {
    const f32x4 t0 = *reinterpret_cast<const f32x4*>(tab + 8 * q + 4 * hi), t1 = *reinterpret_cast<const f32x4*>(tab + 8 * q + 4 * hi + 2);
    const float cs[4] = {t0[0], t0[2], t1[0], t1[2]}, sn[4] = {t0[1], t0[3], t1[1], t1[3]};
#pragma unroll
    for (int j = 0; j < 4; ++j) { const int r = 4 * q + j; float a = y[r], b = y[r + 8]; y[r] = a * cs[j] - b * sn[j]; y[r + 8] = a * sn[j] + b * cs[j]; }
  }
}
DEV void scale_gain(f32x16& y, float s, const float* gain, int hi) {
#pragma unroll
  for (int q = 0; q < 4; ++q) { const f32x4 g = *reinterpret_cast<const f32x4*>(gain + 8 * q + 4 * hi);
#pragma unroll
    for (int j = 0; j < 4; ++j) y[4 * q + j] *= s * g[j]; }
}
DEV float sumsq(const f32x16& y) { float s = 0.f;
#pragma unroll
  for (int r = 0; r < 16; ++r) s = fmaf(y[r], y[r], s);
  return s; }
DEV void store_blk(const f32x16& y, bf16* dst, int hi) {
#pragma unroll
  for (int q = 0; q < 4; ++q) st4(dst + 8 * q + 4 * hi, y[4 * q], y[4 * q + 1], y[4 * q + 2], y[4 * q + 3]);
}

template <int NEL> DEV float row_ssq(const bf16* row, int hi) {
  float s = 0.f;
#pragma unroll
  for (int c = 0; c < NEL / 16; ++c) { const bf16x8 v = *reinterpret_cast<const bf16x8*>(row + (2 * c + hi) * 8);
#pragma unroll
    for (int e = 0; e < 8; ++e) { const float f = bf2f(v[e]); s = fmaf(f, f, s); } }
  return halfsum(s);
}
constexpr int SPITCH = 272;
DEV void lst4(char* p, float a, float b, float c, float d) { u32x2 w = {cvtpk(a, b), cvtpk(c, d)}; *reinterpret_cast<LAS u32x2*>((LAS char*)p) = w; }
template <int MODE, int NBLK>
DEV void store_plain_l(const f32x16* a, float rstd, char* srow, const float* bias, int hi) {
#pragma unroll
  for (int nb = 0; nb < NBLK; ++nb)
#pragma unroll
    for (int q = 0; q < 4; ++q) {
      const int col = nb * 32 + 8 * q + 4 * hi;
      float v0 = a[nb][4 * q] * rstd, v1 = a[nb][4 * q + 1] * rstd, v2 = a[nb][4 * q + 2] * rstd, v3 = a[nb][4 * q + 3] * rstd;
      if constexpr (MODE == 1) { v0 = silu_f(v0); v1 = silu_f(v1); v2 = silu_f(v2); v3 = silu_f(v3); }
      if constexpr (MODE == 2) { f32x4 b = *reinterpret_cast<const f32x4*>(bias + col);
        v0 = sigm_f(v0 + b[0]); v1 = sigm_f(v1 + b[1]); v2 = sigm_f(v2 + b[2]); v3 = sigm_f(v3 + b[3]); }
      lst4(srow + col * 2, v0, v1, v2, v3);
    }
}
DEV void store_blk_l(const f32x16& y, char* sp, int hi) {
#pragma unroll
  for (int q = 0; q < 4; ++q) lst4(sp + (8 * q + 4 * hi) * 2, y[4 * q], y[4 * q + 1], y[4 * q + 2], y[4 * q + 3]);
}
template <int NCOLS> DEV void flush_strip(const char* strip, bf16* gbase, long ld, int nrows, int lane) {
  constexpr int CP = NCOLS / 8, RPI = 64 / CP, NI = 32 / RPI;
  const int rr = lane / CP, ch = lane % CP;
#pragma unroll
  for (int i = 0; i < NI; ++i) { const int row = i * RPI + rr;
    const u32x4 v = *reinterpret_cast<const LAS u32x4*>((const LAS char*)(strip + row * SPITCH + ch * 16));
    if (row < nrows) *reinterpret_cast<u32x4*>(gbase + (long)row * ld + ch * 8) = v; }
}
DEV void p1_tile(const Params& p, int pass, int mt, int nt, char* lds, int wv) {
  char* ws = uni(p.ws);
  int tid = wv * 64 + lane_id(); asm volatile("" : "+v"(tid));
  const int lane = tid & 63, wid = __builtin_amdgcn_readfirstlane(tid >> 6), r32 = lane & 31, hi = lane >> 5;
  const int wm = wid >> 1, wn = wid & 1;
  const bool meta = (mt == 64);
  const long hb0 = meta ? (long)NREAL : (long)pass * TP + mt * 256;
  const bf16* A = (const bf16*)(ws + OFF_HB) + hb0 * 1024;
  const bf16* W = (const bf16*)(ws + OFF_WIN) + (long)nt * 256 * 1024;
  f32x16 acc[2][4]; float dummy[2] = {0.f, 0.f};
#pragma unroll
  for (int a = 0; a < 2; ++a)
#pragma unroll
    for (int b = 0; b < 4; ++b) acc[a][b] = f32x16{};
  gemm_main<2, 4, 4, 2, false>(acc, dummy, A, 1024, W, 1024, 16, lds, tid);
  const int seg = nt * 2 + wn;
  const float* RS = (const float*)(ws + OFF_RSTD);
  char* strip = lds + wid * (32 * SPITCH);
  char* srow = strip + r32 * SPITCH;
#pragma unroll
  for (int mb = 0; mb < 2; ++mb) {
    const int row0 = (wm * 2 + mb) * 32;
    const int rl = row0 + r32;
    const int tl = mt * 256 + rl;
    const long tl0 = (long)mt * 256 + row0;
    const int nrows = meta ? (row0 == 0 ? 16 : 0) : 32;
    const float rstd = RS[hb0 + rl];
    const int pos = (pass < 2) ? (tl & 2047) : tl;
    const int ridx = meta ? 256 : (pos >> 6), cidx = meta ? 64 : (pos & 63);
    f32x16* a = acc[mb];
    if (seg < 10) {
      const bool isq = seg < 8;
      if (isq && meta) continue;
      float ss = halfsum(sumsq(a[0]) + sumsq(a[1]) + sumsq(a[2]) + sumsq(a[3])) * rstd * rstd;
      const float rn = rsqrtf(ss * (1.f / 128.f) + EPS) * rstd * (isq ? QSCALE_A : 1.f);
      const float* gain = isq ? ((const float*)(ws + OFF_SMALL) + 2048) : ((const float*)(ws + OFF_SMALL) + 2176);
      SBAR();
      scale_gain(a[0], rn, gain, hi); scale_gain(a[1], rn, gain + 32, hi);
      rope_pair32(a[0], a[1], (const float2*)(ws + OFF_RAR) + ridx * 32, hi);
      store_blk_l(a[0], srow, hi); store_blk_l(a[1], srow + 64, hi);
      SBAR();
      scale_gain(a[2], rn, gain + 64, hi); scale_gain(a[3], rn, gain + 96, hi);
      rope_pair32(a[2], a[3], (const float2*)(ws + OFF_RAC) + cidx * 32, hi);
      store_blk_l(a[2], srow + 128, hi); store_blk_l(a[3], srow + 192, hi);
      SBAR();
      if (isq) flush_strip<128>(strip, (bf16*)(ws + OFF_QA) + tl0 * 1024 + seg * 128, 1024, nrows, lane);
      else if (!meta) flush_strip<128>(strip, (bf16*)(ws + OFF_KA) + tl0 * 256 + (seg - 8) * 128, 256, nrows, lane);
      else flush_strip<128>(strip, (bf16*)(ws + OFF_KAM) + (long)row0 * 256 + (seg - 8) * 128, 256, nrows, lane);
    } else if (seg < 12) {
      store_plain_l<0, 4>(a, rstd, srow, nullptr, hi);
      if (!meta) flush_strip<128>(strip, (bf16*)(ws + OFF_VA) + tl0 * 256 + (seg - 10) * 128, 256, nrows, lane);
      else flush_strip<128>(strip, (bf16*)(ws + OFF_VAM) + (long)row0 * 256 + (seg - 10) * 128, 256, nrows, lane);
    } else if (seg < 20) {
      if (!meta) { store_plain_l<1, 4>(a, rstd, srow, nullptr, hi); flush_strip<128>(strip, (bf16*)(ws + OFF_GA) + tl0 * 1024 + (seg - 12) * 128, 1024, 32, lane); }
    } else if (seg < 23) {
      if (!meta) { store_plain_l<0, 4>(a, rstd, srow, nullptr, hi); flush_strip<128>(strip, (bf16*)(ws + OFF_CQ) + tl0 * 384 + (seg - 20) * 128, 384, 32, lane); }
    } else if (seg < 25) {
      const long r0 = meta ? (long)TP + row0 : tl0;
      store_plain_l<0, 4>(a, rstd, srow, nullptr, hi); flush_strip<128>(strip, (bf16*)(ws + OFF_CKV) + r0 * 256 + (seg - 23) * 128, 256, 32, lane);
    } else if (seg == 25) {
      const long r0 = meta ? (long)TP + row0 : tl0;
      store_plain_l<0, 2>(a, rstd, srow, nullptr, hi); flush_strip<64>(strip, (bf16*)(ws + OFF_KR) + r0 * 64, 64, 32, lane);
    } else if (seg < 34) {
      if (!meta) { store_plain_l<1, 4>(a, rstd, srow, nullptr, hi); flush_strip<128>(strip, (bf16*)(ws + OFF_GB) + tl0 * 1024 + (seg - 26) * 128, 1024, 32, lane); }
    } else if (seg < 42) {
      if (!meta) { store_plain_l<2, 4>(a, rstd, srow, ((const float*)(ws + OFF_SMALL)) + (seg - 34) * 128, hi); flush_strip<128>(strip, (bf16*)(ws + OFF_SA) + tl0 * 1024 + (seg - 34) * 128, 1024, 32, lane); }
    } else {
      if (!meta) { store_plain_l<2, 4>(a, rstd, srow, ((const float*)(ws + OFF_SMALL)) + 1024 + (seg - 42) * 128, hi); flush_strip<128>(strip, (bf16*)(ws + OFF_SB) + tl0 * 1024 + (seg - 42) * 128, 1024, 32, lane); }
    }
  }
}
DEV int vblock() { const int G = gridDim.x, b = blockIdx.x; return (G % 8 == 0) ? (b % 8) * (G / 8) + b / 8 : b; }
DEV void phase1(const Params& p, int pass, char* lds, int wv) {
  const int G = gridDim.x;
  if (G == 256) {
    const int v = vblock(), x = v >> 5, sl = v & 31;
    for (int j = sl; j < 200; j += 32) p1_tile(p, pass, 8 * x + (j & 7), j >> 3, lds, wv);
    if (pass == 0 && sl == 31 && x < 4) p1_tile(p, pass, 64, x == 0 ? 4 : (x == 1 ? 5 : (x == 2 ? 11 : 12)), lds, wv);
    return;
  }
  const int nt_real = 64 * 25;
  const int ntiles = nt_real + (pass == 0 ? 4 : 0);
  for (int t = blockIdx.x; t < ntiles; t += gridDim.x) {
    if (t < nt_real) p1_tile(p, pass, t / 25, t % 25, lds, wv);
    else { const int k = t - nt_real; p1_tile(p, pass, 64, k == 0 ? 4 : (k == 1 ? 5 : (k == 2 ? 11 : 12)), lds, wv); }
  }
}

DEV void p2_uq_tile(const Params& p, int pass, int mt, int head, char* lds, int wv) {
  char* ws = uni(p.ws);
  int tid = wv * 64 + lane_id(); asm volatile("" : "+v"(tid));
  const int lane = tid & 63, wid = __builtin_amdgcn_readfirstlane(tid >> 6), r32 = lane & 31, hi = lane >> 5;
  const bf16* A = (const bf16*)(ws + OFF_CQ) + (long)mt * 256 * 384;
  const bf16* W = (const bf16*)(ws + OFF_WUQ) + (long)head * 192 * 384;
  f32x16 acc[1][6]; float ssq[1] = {0.f};
#pragma unroll
  for (int b = 0; b < 6; ++b) acc[0][b] = f32x16{};
  gemm_main<1, 6, 8, 1, false>(acc, ssq, A, 384, W, 384, 6, lds, tid);
  const int rl = wid * 32 + r32, tl = mt * 256 + rl;
  const float rstd = rsqrtf(row_ssq<384>(A + (long)rl * 384, hi) * (1.f / 384.f) + EPS);
  SBAR();
  f32x16* a = acc[0];
  float ss = 0.f;
#pragma unroll
  for (int nb = 0; nb < 6; ++nb) ss += sumsq(a[nb]);
  ss = halfsum(ss) * rstd * rstd;
  const float rn = rsqrtf(ss * (1.f / 192.f) + EPS) * rstd * QSCALE_B;
  const int pos = (pass < 2) ? (tl & 2047) : tl;
  bf16* dst = (bf16*)(ws + OFF_QB) + (long)tl * 1536 + head * 192;
#pragma unroll
  for (int nb = 0; nb < 4; ++nb) { SBAR(); scale_gain(a[nb], rn, ((const float*)(ws + OFF_SMALL) + 2304) + nb * 32, hi); store_blk(a[nb], dst + nb * 32, hi); }
  SBAR();
  scale_gain(a[4], rn, ((const float*)(ws + OFF_SMALL) + 2304) + 128, hi);
  rope_in32(a[4], (const float2*)(ws + OFF_RBR) + (pos >> 6) * 16, hi);
  store_blk(a[4], dst + 128, hi);
  SBAR();
  scale_gain(a[5], rn, ((const float*)(ws + OFF_SMALL) + 2304) + 160, hi);
  rope_in32(a[5], (const float2*)(ws + OFF_RBC) + (pos & 63) * 16, hi);
  store_blk(a[5], dst + 160, hi);
  SBAR();
}
DEV void p2_ukv_tile(const Params& p, int pass, int mt, int head, char* lds, int wv) {
  char* ws = uni(p.ws);
  int tid = wv * 64 + lane_id(); asm volatile("" : "+v"(tid));
  const int lane = tid & 63, wid = __builtin_amdgcn_readfirstlane(tid >> 6), r32 = lane & 31, hi = lane >> 5;
  const int wm = wid >> 1, wn = wid & 1;
  const bool meta = (mt == 64);
  const bf16* A = (const bf16*)(ws + OFF_CKV) + (long)mt * 256 * 256;
  const bf16* W = (const bf16*)(ws + OFF_WUKV) + (long)head * 256 * 256;
  float rstdv[2];
#pragma unroll
  for (int mb = 0; mb < 2; ++mb) rstdv[mb] = rsqrtf(row_ssq<256>(A + (long)((wm * 2 + mb) * 32 + r32) * 256, hi) * (1.f / 256.f) + EPS);
  SBAR();
  f32x16 acc[2][4]; float ssq[2] = {0.f, 0.f};
#pragma unroll
  for (int a = 0; a < 2; ++a)
#pragma unroll
    for (int b = 0; b < 4; ++b) acc[a][b] = f32x16{};
  gemm_main<2, 4, 4, 2, false>(acc, ssq, A, 256, W, 256, 4, lds, tid);
  if (wn == 1) {
#pragma unroll
    for (int mb = 0; mb < 2; ++mb) {
      const int rl = (wm * 2 + mb) * 32 + r32, tl = mt * 256 + rl;
      bf16* vd = meta ? (bf16*)(ws + OFF_VBM) + (long)rl * 1024 + head * 128 : (bf16*)(ws + OFF_VB) + (long)tl * 1024 + head * 128;
      if (!meta || rl < 16) store_plain<0, 4>(acc[mb], rstdv[mb], vd, nullptr, hi);
      SBAR();
    }
    return;
  }
#pragma unroll
  for (int mb = 0; mb < 2; ++mb) {
    const int rl = (wm * 2 + mb) * 32 + r32, tl = mt * 256 + rl;
    const float rstd = rstdv[mb];
    f32x16* a = acc[mb];
    const bool dost = (!meta || rl < 16);
    const bf16* krp = (const bf16*)(ws + OFF_KR) + (long)tl * 64;
    float ss = 0.f;
#pragma unroll
    for (int nb = 0; nb < 4; ++nb) ss += sumsq(a[nb]);
    ss *= rstd * rstd;
#pragma unroll
    for (int q = 0; q < 8; ++q) { float t0, t1, t2, t3; ld4(krp + 8 * q + 4 * hi, t0, t1, t2, t3); ss += t0 * t0 + t1 * t1 + t2 * t2 + t3 * t3; }
    ss = halfsum(ss);
    const float rn0 = rsqrtf(ss * (1.f / 192.f) + EPS), rn = rn0 * rstd;
    const int pos = (pass < 2) ? (tl & 2047) : tl;
    const int ridx = meta ? 256 : (pos >> 6), cidx = meta ? 64 : (pos & 63);
    bf16* kd = meta ? (bf16*)(ws + OFF_KBM) + (long)rl * 1536 + head * 192 : (bf16*)(ws + OFF_KB) + (long)tl * 1536 + head * 192;
#pragma unroll
    for (int nb = 0; nb < 4; ++nb) { SBAR(); scale_gain(a[nb], rn, ((const float*)(ws + OFF_SMALL) + 2496) + nb * 32, hi); if (dost) store_blk(a[nb], kd + nb * 32, hi); }
    SBAR();
#pragma unroll
    for (int h2 = 0; h2 < 2; ++h2) {
      f32x16 kr;
#pragma unroll
      for (int q = 0; q < 4; ++q) { float t0, t1, t2, t3; ld4(krp + h2 * 32 + 8 * q + 4 * hi, t0, t1, t2, t3); kr[4 * q] = t0; kr[4 * q + 1] = t1; kr[4 * q + 2] = t2; kr[4 * q + 3] = t3; }
      scale_gain(kr, rn0, ((const float*)(ws + OFF_SMALL) + 2496) + 128 + h2 * 32, hi);
      rope_in32(kr, (const float2*)(ws + (h2 == 0 ? OFF_RBR : OFF_RBC)) + (h2 == 0 ? ridx : cidx) * 16, hi);
      if (dost) store_blk(kr, kd + 128 + h2 * 32, hi);
      SBAR();
    }
  }
}
DEV void phase2(const Params& p, int pass, char* lds, int wv) {
  const int G = gridDim.x;
  if (G == 256) {
    const int v = vblock(), x = v >> 5, sl = v & 31;
    for (int j = sl; j < 128; j += 32) {
      const int mt = 8 * x + (j & 7), head = (j >> 3) & 7;
      if (j < 64) p2_ukv_tile(p, pass, mt, head, lds, wv); else p2_uq_tile(p, pass, mt, head, lds, wv);
    }
    if (pass == 0 && sl == 0) p2_ukv_tile(p, pass, 64, x, lds, wv);
    return;
  }
  const int n_kv = (64 + (pass == 0 ? 1 : 0)) * 8, n_q = 64 * 8;
  for (int t = blockIdx.x; t < n_kv + n_q; t += gridDim.x) {
    if (t < n_kv) p2_ukv_tile(p, pass, t >> 3, t & 7, lds, wv);
    else { const int u = t - n_kv; p2_uq_tile(p, pass, u >> 3, u & 7, lds, wv); }
  }
}

constexpr int KVBLK = 64;
constexpr float THR = 8.f;
template <int DQK> struct AC {
  static constexpr float SCALE = DQK == 128 ? 0.088388347648318440f : 0.072168783648703220f;
  static constexpr float C = SCALE * 1.4426950408889634f;
  static constexpr int KPITCH = DQK * 2 + 16;
  static constexpr int SHM_K = KVBLK * KPITCH;
};
DEV void partialSM(f32x16& p0) {
#pragma unroll
  for (int r = 0; r < 16; ++r) p0[r] = __builtin_amdgcn_exp2f(p0[r]);
}
DEV void finishSM(f32x16& p0, f32x16& p1, float& l_reg, bf16x8& pa0, bf16x8& pa1, bf16x8& pa2, bf16x8& pa3) {
#pragma unroll
  for (int r = 0; r < 16; ++r) p1[r] = __builtin_amdgcn_exp2f(p1[r]);
  float ps = 0;
#pragma unroll
  for (int r = 0; r < 16; ++r) ps += p0[r];
#pragma unroll
  for (int r = 0; r < 16; ++r) ps += p1[r];
  { auto rr = __builtin_amdgcn_permlane32_swap(__float_as_uint(ps), __float_as_uint(ps), false, false);
    ps = __uint_as_float(rr[0]) + __uint_as_float(rr[1]); }
  l_reg += ps;
#define PK4(P, BASE, OUT) do { unsigned a0 = cvtpk(P[BASE + 0], P[BASE + 1]), a1 = cvtpk(P[BASE + 2], P[BASE + 3]);   \
    unsigned b0 = cvtpk(P[BASE + 4], P[BASE + 5]), b1 = cvtpk(P[BASE + 6], P[BASE + 7]);                              \
    auto r0 = __builtin_amdgcn_permlane32_swap(a0, b0, false, false); auto r1 = __builtin_amdgcn_permlane32_swap(a1, b1, false, false); \
    u32x4 w = {r0[0], r1[0], r0[1], r1[1]}; OUT = *reinterpret_cast<bf16x8*>(&w); } while (0)
  PK4(p0, 0, pa0); PK4(p0, 8, pa1); PK4(p1, 0, pa2); PK4(p1, 8, pa3);
#undef PK4
}
template <int DQK> DEV int koff(int row, int slot) { return row * AC<DQK>::KPITCH + slot * 16; }
constexpr int QPITCH = 272;
template <int DQK>
DEV void qkt(f32x16& p0, f32x16& p1, const char* Ks, const bf16x8* qr, const char* Ql, int r32, int hi) {
  p0 = f32x16{}; p1 = f32x16{};
  constexpr int KP = AC<DQK>::KPITCH;
  if constexpr (DQK == 192) asm volatile("" : "+v"(r32));
  const char* kb = Ks + r32 * KP + hi * 16;
  const char* qb = Ql + r32 * QPITCH + hi * 16;
#pragma unroll
  for (int d0 = 0; d0 < DQK / 16; ++d0) {
    bf16x8 b0 = *reinterpret_cast<const bf16x8*>(kb + d0 * 32);
    bf16x8 b1 = *reinterpret_cast<const bf16x8*>(kb + d0 * 32 + 32 * KP);
    bf16x8 q;
    if (DQK == 128 || d0 < 4) q = qr[d0];
    else q = *reinterpret_cast<const bf16x8*>(qb + (d0 - 4) * 32);
    p0 = __builtin_amdgcn_mfma_f32_32x32x16_bf16(b0, q, p0, 0, 0, 0);
    p1 = __builtin_amdgcn_mfma_f32_32x32x16_bf16(b1, q, p1, 0, 0, 0);
  }
}
DEV int v_st(int k, int c) { const int kk = (k & ~0xC) | ((k & 4) << 1) | ((k & 8) >> 1); return ((kk >> 3) * 4 + (c >> 5)) * 512 + ((kk & 7) * 32 + (c & 31)) * 2; }
DEV int v_rd_base(int lane) { return ((lane & 3) << 3) | (((lane >> 2) & 3) << 6) | (((lane >> 4) & 1) << 5) | (((lane >> 5) & 1) << 8); }
constexpr int v_rd_off(int d0, int ks, int half) { return d0 * 512 + ks * 4096 + half * 2048; }
template <int OFF> DEV s16x4 tr_read(int vb) {
  s16x4 r; asm volatile("ds_read_b64_tr_b16 %0, %1 offset:%2" : "=&v"(r) : "v"(vb), "i"(OFF) : "memory"); return r;
}
template <int D0> DEV void pv_one(f32x16& od, int vb, bf16x8 pa0, bf16x8 pa1, bf16x8 pa2, bf16x8 pa3) {
  const s16x4 l0 = tr_read<v_rd_off(D0, 0, 0)>(vb), h0 = tr_read<v_rd_off(D0, 0, 1)>(vb), l1 = tr_read<v_rd_off(D0, 1, 0)>(vb), h1 = tr_read<v_rd_off(D0, 1, 1)>(vb);
  const s16x4 l2 = tr_read<v_rd_off(D0, 2, 0)>(vb), h2 = tr_read<v_rd_off(D0, 2, 1)>(vb), l3 = tr_read<v_rd_off(D0, 3, 0)>(vb), h3 = tr_read<v_rd_off(D0, 3, 1)>(vb);
  asm volatile("s_waitcnt lgkmcnt(0)" ::: "memory"); SBAR();
#define PK(L, H) (bf16x8){L[0], L[1], L[2], L[3], H[0], H[1], H[2], H[3]}
  od = __builtin_amdgcn_mfma_f32_32x32x16_bf16(pa0, PK(l0, h0), od, 0, 0, 0);
  od = __builtin_amdgcn_mfma_f32_32x32x16_bf16(pa1, PK(l1, h1), od, 0, 0, 0);
  od = __builtin_amdgcn_mfma_f32_32x32x16_bf16(pa2, PK(l2, h2), od, 0, 0, 0);
  od = __builtin_amdgcn_mfma_f32_32x32x16_bf16(pa3, PK(l3, h3), od, 0, 0, 0);
#undef PK
}
DEV void pv_d0(f32x16* o, int vb, bf16x8 pa0, bf16x8 pa1, bf16x8 pa2, bf16x8 pa3) {
  pv_one<0>(o[0], vb, pa0, pa1, pa2, pa3); pv_one<1>(o[1], vb, pa0, pa1, pa2, pa3); pv_one<2>(o[2], vb, pa0, pa1, pa2, pa3); pv_one<3>(o[3], vb, pa0, pa1, pa2, pa3);
}

template <int DQK, int LDQ, int LDK, int LDV, int SD>
DEV void attn_body(const bf16* __restrict__ Qb, const bf16* __restrict__ Kh, const bf16* __restrict__ Vh,
                   const bf16* __restrict__ Km, const bf16* __restrict__ Vm, bf16* Ob, const bf16* __restrict__ Gb, int NT, char* lds, int wv) {
  constexpr int SHM_V = KVBLK * 128 * 2, SHM_K = AC<DQK>::SHM_K, CPR = DQK / 8, NCH = 64 * CPR / NTHR, ND0 = DQK / 16;
  int tid = wv * 64 + lane_id(); asm volatile("" : "+v"(tid));
  const int wid = __builtin_amdgcn_readfirstlane(tid >> 6), lane = tid & 63, r32 = lane & 31, hi = lane >> 5;
  char* V_lds = lds; char* K_lds = lds + 2 * SHM_V;
  float* wsf = (float*)(lds + 2 * SHM_V + 2 * SHM_K) + wid * 64; float* li_l = wsf;
  constexpr int NQR = DQK == 128 ? 8 : 4;
  float l_reg = 0; f32x16 o[4] = {}; bf16x8 qr[NQR];
  const bf16* Qw = Qb + (long)(wid * 32 + r32) * LDQ + hi * 8;
#pragma unroll
  for (int d0 = 0; d0 < NQR; ++d0) qr[d0] = *reinterpret_cast<const bf16x8*>(Qw + d0 * 16);
  char* Ql = lds + 86016 + wid * (32 * QPITCH);
  if constexpr (ND0 > NQR) {
#pragma unroll
    for (int d0 = NQR; d0 < ND0; ++d0)
      *reinterpret_cast<bf16x8*>(Ql + r32 * QPITCH + ((d0 - 4) * 2 + hi) * 16) = *reinterpret_cast<const bf16x8*>(Qw + d0 * 16);
  }
  const int sr = tid >> 4, sc = (tid & 15) * 8, vst0 = v_st(sr, sc);
  const unsigned vgo = (unsigned)(sr * LDV + sc) * 2u;
  const unsigned kgo0 = (unsigned)((tid >> 3) * LDK + (tid & 7) * 8) * 2u; const int kst0 = koff<DQK>(tid >> 3, tid & 7);
  const int vb0 = (int)(uintptr_t)V_lds + v_rd_base(lane);
  struct { u32x4 vs0, vs1, ks[NCH]; } sr_[SD];
  const __amdgpu_buffer_rsrc_t rk_ = __builtin_amdgcn_make_buffer_rsrc((void*)Kh, 0, 0x7fffffff, 0x00020000);
  const __amdgpu_buffer_rsrc_t rv_ = __builtin_amdgcn_make_buffer_rsrc((void*)Vh, 0, 0x7fffffff, 0x00020000);
#define KST(c) (kst0 + (c) * 128)
#define SLOAD0(i) do { const char* kp_ = (const char*)Km; const char* vp_ = (const char*)Vm; \
    sr_[i].vs0 = *reinterpret_cast<const u32x4*>(vp_ + vgo); sr_[i].vs1 = *reinterpret_cast<const u32x4*>(vp_ + 32 * LDV * 2 + vgo); \
    _Pragma("unroll") for (int c = 0; c < NCH; ++c) sr_[i].ks[c] = *reinterpret_cast<const u32x4*>(kp_ + c * 128 + kgo0); } while (0)
#define SLOAD(i, t) do { const int ko_ = ((t) - 1) * (KVBLK * LDK * 2), vo_ = ((t) - 1) * (KVBLK * LDV * 2);     \
    sr_[i].vs0 = __builtin_amdgcn_raw_buffer_load_b128(rv_, (int)vgo, vo_, 0); sr_[i].vs1 = __builtin_amdgcn_raw_buffer_load_b128(rv_, (int)vgo, vo_ + 32 * LDV * 2, 0); \
    _Pragma("unroll") for (int c = 0; c < NCH; ++c) sr_[i].ks[c] = __builtin_amdgcn_raw_buffer_load_b128(rk_, (int)kgo0 + c * 128, ko_, 0); } while (0)
#define SWRITE(b, i) do { *reinterpret_cast<u32x4*>(V_lds + (b) * SHM_V + vst0) = sr_[i].vs0; *reinterpret_cast<u32x4*>(V_lds + (b) * SHM_V + 8192 + vst0) = sr_[i].vs1; \
    _Pragma("unroll") for (int c = 0; c < NCH; ++c) *reinterpret_cast<u32x4*>(K_lds + (b) * SHM_K + KST(c)) = sr_[i].ks[c]; } while (0)
#define SWAIT() do { if constexpr (SD == 2) asm volatile("s_waitcnt vmcnt(%0)" :: "n"(2 + NCH) : "memory"); else asm volatile("s_waitcnt vmcnt(0)" ::: "memory"); } while (0)
  f32x16 pA0, pA1, pB0, pB1; bf16x8 pa0, pa1, pa2, pa3;
  constexpr int SE = 0, SO = SD - 1;
  SLOAD0(SE); asm volatile("s_waitcnt vmcnt(0)" ::: "memory"); SWRITE(0, SE); __syncthreads();
  qkt<DQK>(pA0, pA1, K_lds, qr, Ql, r32, hi);
#pragma unroll
  for (int r = 8; r < 16; ++r) pA0[r] = -1e30f;
#pragma unroll
  for (int r = 0; r < 16; ++r) pA1[r] = -1e30f;
  partialSM(pA0);
  SLOAD(SO, 1); if constexpr (SD == 2) { SLOAD(SE, 2); }
  SWAIT(); SWRITE(1, SO); __syncthreads();
  for (int j = 1; j + 1 < NT; j += 2) {
    SBAR(); qkt<DQK>(pB0, pB1, K_lds + SHM_K, qr, Ql, r32, hi);
    finishSM(pA0, pA1, l_reg, pa0, pa1, pa2, pa3); SBAR();
    if (SD == 1 || j + 2 < NT) SLOAD(SO, j + SD); SBAR();
    pv_d0(o, vb0, pa0, pa1, pa2, pa3); partialSM(pB0);
    __syncthreads(); SWAIT(); SWRITE(0, SE); SBAR();
    __syncthreads();
    SBAR(); qkt<DQK>(pA0, pA1, K_lds, qr, Ql, r32, hi);
    finishSM(pB0, pB1, l_reg, pa0, pa1, pa2, pa3); SBAR();
    if (j + 1 + SD < NT) SLOAD(SE, j + 1 + SD); SBAR();
    pv_d0(o, vb0 + SHM_V, pa0, pa1, pa2, pa3); partialSM(pA0);
    __syncthreads(); SWAIT(); if (j + 2 < NT) SWRITE(1, SO); SBAR();
    __syncthreads();
  }
  finishSM(pA0, pA1, l_reg, pa0, pa1, pa2, pa3); SBAR();
  pv_d0(o, vb0, pa0, pa1, pa2, pa3);
  {
    const int le = lane_id(), r32e = le & 31, hie = le >> 5;
    if (hie == 0) li_l[r32e] = l_reg; asm volatile("s_waitcnt lgkmcnt(0)" ::: "memory");
    float rli[16];
#pragma unroll
    for (int r = 0; r < 16; ++r) rli[r] = __builtin_amdgcn_rcpf(li_l[crow(r, hie)]);
    const unsigned eoff = (unsigned)((wid * 32 + 4 * hie) * 1024 + r32e) * 2u;
#pragma unroll
    for (int r = 0; r < 16; ++r) {
#pragma unroll
      for (int d0 = 0; d0 < 4; ++d0) {
        const long cst = (long)(((r & 3) + 8 * (r >> 2)) * 1024) * 2 + d0 * 64;
        const float g = bf2f(*reinterpret_cast<const short*>(((const char*)Gb + cst) + eoff));
        const unsigned w = cvtpk(o[d0][r] * rli[r] * g, 0.f);
        *reinterpret_cast<unsigned short*>(((char*)Ob + cst) + eoff) = (unsigned short)(w & 0xffffu); } }
  }
#undef SLOAD
#undef SLOAD0
#undef KST
#undef SWRITE
#undef SWAIT
}
DEV void phase3(const Params& p, int pass, char* lds, int wv) {
  char* ws = uni(p.ws);
  const int nkeys = pass < 2 ? 2048 : 16384, NT = nkeys / 64 + 1;
  const bool xmap = (gridDim.x == 256);
  const int vb_ = vblock(), vx = vb_ >> 5, vs = vb_ & 31;
  for (int it0 = blockIdx.x; it0 < 1024; it0 += gridDim.x) {
    __syncthreads();
    const int rnd = it0 >> 8;
    int it = it0;
    if (xmap) {
      int hd_ = (rnd & 1) * 4 + (vs >> 3), qb_ = vx * 8 + (vs & 7);
      if (pass == 2 && rnd < 2) { hd_ = (vx >> 2) * 4 + (vs >> 3); qb_ = ((rnd & 1) * 4 + (vx & 3)) * 8 + (vs & 7); }
      it = (rnd >> 1) * 512 + (hd_ << 6) + qb_;
    }
    const int i = it & 511, head = i >> 6, qb = i & 63;
    const long t0 = (long)qb * 256, kv0 = pass < 2 ? (long)(qb >> 3) * 2048 : 0;
    if (it < 512) {
      const int kvh = head >> 2;
      bf16* Q = (bf16*)(ws + OFF_QA) + t0 * 1024 + head * 128;
      attn_body<128, 1024, 256, 256, 2>(Q, (const bf16*)(ws + OFF_KA) + kv0 * 256 + kvh * 128, (const bf16*)(ws + OFF_VA) + kv0 * 256 + kvh * 128,
                                        (const bf16*)(ws + OFF_KAM) + kvh * 128, (const bf16*)(ws + OFF_VAM) + kvh * 128,
                                        Q, (const bf16*)(ws + OFF_GA) + t0 * 1024 + head * 128, NT, lds, wv);
    } else {
      bf16* O = (bf16*)(ws + OFF_HB) + ((long)pass * TP + t0) * 1024 + head * 128;
      attn_body<192, 1536, 1536, 1024, 1>((const bf16*)(ws + OFF_QB) + t0 * 1536 + head * 192, (const bf16*)(ws + OFF_KB) + kv0 * 1536 + head * 192,
                                          (const bf16*)(ws + OFF_VB) + kv0 * 1024 + head * 128, (const bf16*)(ws + OFF_KBM) + head * 192,
                                          (const bf16*)(ws + OFF_VBM) + head * 128, O, (const bf16*)(ws + OFF_GB) + t0 * 1024 + head * 128, NT, lds, wv);
    }
  }
}

DEV void p4_tile(const Params& p, int pass, int mt, int nt, char* lds, int wv) {
  char* ws = uni(p.ws);
  int tid = wv * 64 + lane_id(); asm volatile("" : "+v"(tid));
  const int lane = tid & 63, wid = __builtin_amdgcn_readfirstlane(tid >> 6), r32 = lane & 31, hi = lane >> 5;
  const int wm = wid >> 1, wn = wid & 1;
  f32x16 acc[2][4]; float dummy[2] = {0.f, 0.f};
#pragma unroll
  for (int a = 0; a < 2; ++a)
#pragma unroll
    for (int b = 0; b < 4; ++b) acc[a][b] = f32x16{};
  gemm_main<2, 4, 4, 2, false>(acc, dummy, (const bf16*)(ws + OFF_QA) + (long)mt * 256 * 1024, 1024,
                               (const bf16*)(ws + OFF_WPA) + (long)nt * 256 * 1024, 1024, 16, lds, tid);
#pragma unroll
  for (int mb = 0; mb < 2; ++mb) {
    const long tl = (long)mt * 256 + (wm * 2 + mb) * 32 + r32;
    const bf16* sa = (const bf16*)(ws + OFF_SA) + tl * 1024 + nt * 256 + wn * 128;
    const bf16* sb = (const bf16*)(ws + OFF_SB) + tl * 1024 + nt * 256 + wn * 128;
#pragma unroll
    for (int nb = 0; nb < 4; ++nb)
#pragma unroll
      for (int q = 0; q < 4; ++q) {
        float a0, a1, a2, a3, b0, b1, b2, b3; const int col = nb * 32 + 8 * q + 4 * hi;
        ld4(sa + col, a0, a1, a2, a3); ld4(sb + col, b0, b1, b2, b3);
        acc[mb][nb][4 * q] *= a0 / b0; acc[mb][nb][4 * q + 1] *= a1 / b1; acc[mb][nb][4 * q + 2] *= a2 / b2; acc[mb][nb][4 * q + 3] *= a3 / b3;
      }
  }
  gemm_main<2, 4, 4, 2, false>(acc, dummy, (const bf16*)(ws + OFF_HB) + ((long)pass * TP + mt * 256) * 1024, 1024,
                               (const bf16*)(ws + OFF_WPB) + (long)nt * 256 * 1024, 1024, 16, lds, tid);
#pragma unroll
  for (int mb = 0; mb < 2; ++mb) {
    const long tl = (long)mt * 256 + (wm * 2 + mb) * 32 + r32;
    const bf16* sb = (const bf16*)(ws + OFF_SB) + tl * 1024 + nt * 256 + wn * 128;
    bf16* md = (bf16*)(ws + OFF_MM) + tl * 1024 + nt * 256 + wn * 128;
#pragma unroll
    for (int nb = 0; nb < 4; ++nb)
#pragma unroll
      for (int q = 0; q < 4; ++q) {
        float b0, b1, b2, b3; const int col = nb * 32 + 8 * q + 4 * hi;
        ld4(sb + col, b0, b1, b2, b3);
        st4(md + col, acc[mb][nb][4 * q] * b0, acc[mb][nb][4 * q + 1] * b1, acc[mb][nb][4 * q + 2] * b2, acc[mb][nb][4 * q + 3] * b3);
      }
  }
}
DEV void p5_tile(const Params& p, int pass, int mt, int nt, char* lds, int wv) {
  char* ws = uni(p.ws);
  int tid = wv * 64 + lane_id(); asm volatile("" : "+v"(tid));
  const int lane = tid & 63, wid = __builtin_amdgcn_readfirstlane(tid >> 6), r32 = lane & 31, hi = lane >> 5;
  const int wm = wid >> 1, wn = wid & 1;
  f32x16 acc[2][4]; float dummy[2] = {0.f, 0.f};
#pragma unroll
  for (int a = 0; a < 2; ++a)
#pragma unroll
    for (int b = 0; b < 4; ++b) acc[a][b] = f32x16{};
  gemm_main<2, 4, 4, 2, false>(acc, dummy, (const bf16*)(ws + OFF_MM) + (long)mt * 256 * 1024, 1024,
                               (const bf16*)(ws + OFF_WO) + (long)nt * 256 * 1024, 1024, 16, lds, tid);
  constexpr int P5PITCH = 528;
  char* strip = lds + wid * (32 * P5PITCH);
#pragma unroll
  for (int mb = 0; mb < 2; ++mb) {
    const long g0 = (long)pass * TP + (long)mt * 256 + (wm * 2 + mb) * 32;
    const float* xs0 = (pass < 2 ? uni(p.x_prompt) + g0 * 1024 : uni(p.x_sample) + (g0 - 32768) * 1024) + nt * 256 + wn * 128;
    float* od0 = uni(p.out) + g0 * 1024 + nt * 256 + wn * 128;
#pragma unroll
    for (int nb = 0; nb < 4; ++nb)
#pragma unroll
      for (int q = 0; q < 4; ++q) {
        const f32x4 v = {acc[mb][nb][4 * q], acc[mb][nb][4 * q + 1], acc[mb][nb][4 * q + 2], acc[mb][nb][4 * q + 3]};
        *reinterpret_cast<LAS f32x4*>((LAS char*)(strip + r32 * P5PITCH + (nb * 32 + 8 * q + 4 * hi) * 4)) = v;
      }
#pragma unroll
    for (int i2 = 0; i2 < 16; ++i2) {
      const int row = i2 * 2 + (lane >> 5), ch = lane & 31;
      const f32x4 a = *reinterpret_cast<const LAS f32x4*>((const LAS char*)(strip + row * P5PITCH + ch * 16));
      f32x4 x = *reinterpret_cast<const f32x4*>(xs0 + (long)row * 1024 + ch * 4);
      x[0] += a[0]; x[1] += a[1]; x[2] += a[2]; x[3] += a[3];
      *reinterpret_cast<f32x4*>(od0 + (long)row * 1024 + ch * 4) = x;
    }
  }
}

#define XB_TMO      128
#define XB_XCNT(j)  (256  + 64 * (j))
#define XB_XSUB(j)  (1280 + 64 * (j))
#define XB_XGEN(j)  (2304 + 64 * (j))
#define XB_TOP      3328
#define XB_TOPGEN   3392
#define XB_SPIN_CAP (1u << 18)
DEV unsigned xb_ld(unsigned* p)              { return __hip_atomic_load(p, __ATOMIC_RELAXED, __HIP_MEMORY_SCOPE_AGENT); }
DEV unsigned xb_add(unsigned* p, unsigned v) { return __hip_atomic_fetch_add(p, v, __ATOMIC_RELAXED, __HIP_MEMORY_SCOPE_AGENT); }
DEV unsigned xb_xcc_id() { return (unsigned)__builtin_amdgcn_s_getreg((3 << 11) | 20) & 0xFu; }
#define XB_SPIN(cond, bar) do { unsigned _sp = 0; while (cond) { __builtin_amdgcn_s_sleep(1); \
    if ((++_sp & 255u) == 0u) { if (xb_ld(&(bar)[XB_TMO])) break; if (_sp > XB_SPIN_CAP) { atomicAdd(&(bar)[XB_TMO], 1u); break; } } } } while (0)
DEV void xcd_barrier_complete(unsigned* bar, unsigned x, unsigned& nloc, unsigned& nx) {
  const unsigned G = gridDim.x;
  unsigned sum, cnt, mine, sp = 0u;
  for (;;) {
    sum = 0u; cnt = 0u; mine = 0u;
#pragma unroll
    for (unsigned j = 0; j < 16; ++j) { const unsigned c = xb_ld(&bar[XB_XCNT(j)]); sum += c; cnt += (c > 0u) ? 1u : 0u; mine = (j == x) ? c : mine; }
    if (sum == G) break;
    __builtin_amdgcn_s_sleep(1);
    if ((++sp & 255u) == 0u) { if (xb_ld(&bar[XB_TMO])) break; if (sp > XB_SPIN_CAP) { atomicAdd(&bar[XB_TMO], 1u); break; } }
  }
  nloc = mine > 0u ? mine : 1u; nx = cnt > 0u ? cnt : 1u;
}
DEV void xcd_barrier(unsigned* bar, unsigned x, volatile LAS unsigned* st, int wv) {
  asm volatile("s_waitcnt vmcnt(0)" ::: "memory");
  __syncthreads();
  if (wv == 0 && lane_id() == 0) {
    __builtin_amdgcn_s_waitcnt(0);
    unsigned nloc = st[0], nx = st[1];
    if (nloc == 0u) { xcd_barrier_complete(bar, x, nloc, nx); st[0] = nloc; st[1] = nx; }
    const unsigned old = xb_add(&bar[XB_XSUB(x)], 1u);
    const unsigned gen = old / nloc;
    if (old + 1u == (gen + 1u) * nloc) {
      __builtin_amdgcn_fence(__ATOMIC_RELEASE, "agent");
      asm volatile("s_waitcnt vmcnt(0)" ::: "memory");
      const unsigned og = xb_add(&bar[XB_TOP], 1u);
      const unsigned tg = og / nx;
      if (og + 1u == (tg + 1u) * nx) xb_add(&bar[XB_TOPGEN], 1u);
      else XB_SPIN(xb_ld(&bar[XB_TOPGEN]) == tg, bar);
      __builtin_amdgcn_fence(__ATOMIC_ACQUIRE, "agent");
      xb_add(&bar[XB_XGEN(x)], 1u);
      asm volatile("s_waitcnt vmcnt(0)" ::: "memory");
    } else {
      XB_SPIN(xb_ld(&bar[XB_XGEN(x)]) == gen, bar);
      __builtin_amdgcn_fence(__ATOMIC_ACQUIRE, "agent");
      asm volatile("s_waitcnt vmcnt(0)" ::: "memory");
    }
  }
  __syncthreads();
}

__global__ void __launch_bounds__(NTHR) mega_fwd(Params p) {
  extern __shared__ __attribute__((aligned(16))) char lds[];
  cg::grid_group grid = cg::this_grid();
  const int wv = __builtin_amdgcn_readfirstlane((int)threadIdx.x >> 6);
#ifndef PHM
#define PHM 63
#endif
  volatile LAS unsigned* xst = (volatile LAS unsigned*)(lds + LDS_XB_OFF);
  const unsigned xcc = xb_xcc_id();
  if (wv == 0 && lane_id() == 0) { xst[0] = 0u; xst[1] = 0u; xst[2] = 0u; xst[3] = 0u; (void)xb_add(&((unsigned*)(uni(p.ws) + OFF_BAR))[XB_XCNT(xcc)], 1u); }
  __syncthreads();
#define GSYNC() xcd_barrier((unsigned*)(uni(p.ws) + OFF_BAR), xcc, xst, wv)
  if (PHM & 1) phase0(p, lds, wv);
  grid.sync();
  for (int pass = 0; pass < 3; ++pass) {
    if (PHM & 2) phase1(p, pass, lds, wv);
    GSYNC();
    if (PHM & 4) phase2(p, pass, lds, wv);
    GSYNC();
    if (PHM & 8) phase3(p, pass, lds, wv);
    GSYNC();
    if (PHM & 16) for (int t = vblock(); t < 256; t += gridDim.x) p4_tile(p, pass, (t >> 5) * 8 + (t & 7), (t >> 3) & 3, lds, wv);
    GSYNC();
    if (PHM & 32) for (int t = vblock(); t < 256; t += gridDim.x) p5_tile(p, pass, (t >> 5) * 8 + (t & 7), (t >> 3) & 3, lds, wv);
  }
#undef GSYNC
}

extern "C" void kernel_launch(void* const* d_in, const int* in_sizes, int n_in, void* d_out, int out_size, void* d_ws, size_t ws_size, hipStream_t stream) {
  static int grid_blocks = 0;
  if (grid_blocks == 0) {
    if (n_in != 17 || ws_size < WS_END || out_size != NREAL * DM) {
      fprintf(stderr, "kernel_launch: unexpected shapes: n_in %d out %d ws %zu (need %zu)\n", n_in, out_size, ws_size, (size_t)WS_END); grid_blocks = -1; return; }
    int dev = 0, cus = 0, per_cu = 0;
    (void)hipGetDevice(&dev);
    (void)hipDeviceGetAttribute(&cus, hipDeviceAttributeMultiprocessorCount, dev);
    if (hipFuncSetAttribute((const void*)mega_fwd, hipFuncAttributeMaxDynamicSharedMemorySize, LDS_BYTES) != hipSuccess) {
      fprintf(stderr, "kernel_launch: hipFuncSetAttribute failed\n"); grid_blocks = -1; return; }
    if (hipOccupancyMaxActiveBlocksPerMultiprocessor(&per_cu, (const void*)mega_fwd, NTHR, LDS_BYTES) != hipSuccess || per_cu < 1) {
      fprintf(stderr, "kernel_launch: occupancy query failed (%d)\n", per_cu); per_cu = 1; (void)hipGetLastError(); }
    grid_blocks = cus * per_cu;
  }
  if (grid_blocks < 0) return;
  Params p{};
  p.x_prompt = (const float*)d_in[0]; p.x_sample = (const float*)d_in[1]; p.meta = (const float*)d_in[2]; p.norm_gain = (const float*)d_in[3];
  p.w_in = (const float*)d_in[4]; p.b_merge = (const float*)d_in[5]; p.qna = (const float*)d_in[6]; p.kna = (const float*)d_in[7];
  p.cqn = (const float*)d_in[8]; p.ckvn = (const float*)d_in[9]; p.w_uq = (const float*)d_in[10]; p.w_ukv = (const float*)d_in[11];
  p.qnb = (const float*)d_in[12]; p.knb = (const float*)d_in[13]; p.wpa = (const float*)d_in[14]; p.wpb = (const float*)d_in[15]; p.wo = (const float*)d_in[16];
  p.out = (float*)d_out; p.ws = (char*)d_ws;
  if (hipMemsetAsync((char*)d_ws + OFF_BAR, 0, BAR_BYTES, stream) != hipSuccess) { fprintf(stderr, "kernel_launch: barrier memset failed\n"); return; }
  void* args[] = {&p};
  hipError_t e = hipLaunchCooperativeKernel((const void*)mega_fwd, dim3(grid_blocks), dim3(NTHR), args, LDS_BYTES, stream);
  if (e != hipSuccess) fprintf(stderr, "cooperative launch failed: %s (grid %d)\n", hipGetErrorString(e), grid_blocks);
}
```
